# Optimizing an MI355X kernel written in HIP

```python
import jax, jax.numpy as jnp
from jax import lax
import numpy as np

D_MODEL = 1024
BATCH = 8
SEQ = 2048
DEPTH = 1
DEC_BATCH = 8
DEC_SEQ = 16
PAST_LEN = 1024

CHUNK = 64
D_MIX = D_MODEL
D_CONV = D_MIX // 2
CONV_W = 3
N_HEADS = 8
HEAD_DIM = (D_MIX - D_CONV) // N_HEADS
N_KV_HEADS = 2
GROUP = N_HEADS // N_KV_HEADS
ROT_DIM = HEAD_DIM // 4
ROPE_THETA = 500000.0
N_IDX_HEADS = 8
IDX_DIM = 64
IDX_ROT_DIM = IDX_DIM // 4
TOP_K = 256
Q_BLOCK = 128
D_FF = 2816
EPS = 1e-6

SPLITS = (D_CONV, D_CONV, D_CONV,
          N_HEADS * HEAD_DIM, N_KV_HEADS * HEAD_DIM, N_KV_HEADS * HEAD_DIM,
          N_IDX_HEADS * IDX_DIM, IDX_DIM, N_IDX_HEADS)
D_IN = sum(SPLITS)
SPLIT_POINTS = tuple(int(s) for s in np.cumsum(SPLITS)[:-1])

kernel_name = 'hybrid_conv_dsa_macaron_stream_step'


def rmsnorm(x, g):
    xf = x.astype(jnp.float32)
    y = xf * lax.rsqrt(jnp.mean(xf * xf, axis=-1, keepdims=True) + EPS)
    return (y * g.astype(jnp.float32)).astype(x.dtype)


def swiglu(x, w_gate, w_up, w_down):
    return (jax.nn.silu(x @ w_gate) * (x @ w_up)) @ w_down


def rope_partial(x, pos, rot):
    half = rot // 2
    inv = ROPE_THETA ** (-jnp.arange(half, dtype=jnp.float32) * (2.0 / rot))
    ang = pos.astype(jnp.float32)[:, None] * inv[None, :]
    cos = jnp.cos(ang)[None, :, None, :]
    sin = jnp.sin(ang)[None, :, None, :]
    xr = x[..., :rot].astype(jnp.float32)
    x1, x2 = xr[..., :half], xr[..., half:]
    xr = jnp.concatenate([x1 * cos - x2 * sin, x1 * sin + x2 * cos], axis=-1).astype(x.dtype)
    return jnp.concatenate([xr, x[..., rot:]], axis=-1)


def dsa_attention(q, q_idx, w_idx, k, v, k_idx, q_pos, n_sel):
    B, T = q.shape[0], q.shape[1]
    S = k.shape[1]
    qb = Q_BLOCK if T % Q_BLOCK == 0 else T
    nb = T // qb
    key_pos = jnp.arange(S)

    def blocks(a):
        return jnp.moveaxis(a.reshape((B, nb, qb) + a.shape[2:]), 1, 0)

    def one_block(args):
        qq, qi, wi, pp = args
        limit = (pp // CHUNK + 1) * CHUNK
        adm = key_pos[None, :] < limit[:, None]
        dots = jnp.einsum('bthd,bsd->bths', qi.astype(jnp.float32), k_idx.astype(jnp.float32)) * (IDX_DIM ** -0.5)
        score = jnp.einsum('bths,bth->bts', jax.nn.relu(dots), wi.astype(jnp.float32))
        score = jnp.where(adm[None], score, -jnp.inf)
        _, sel = lax.top_k(score, n_sel)
        valid = sel < limit[None, :, None]
        k_sel = jax.vmap(lambda kb, ib: kb[ib])(k, sel)
        v_sel = jax.vmap(lambda vb, ib: vb[ib])(v, sel)
        qg = qq.reshape(B, qb, N_KV_HEADS, GROUP, HEAD_DIM)
        logits = jnp.einsum('btkgd,btnkd->btkgn', qg, k_sel).astype(jnp.float32) * (HEAD_DIM ** -0.5)
        logits = jnp.where(valid[:, :, None, None, :], logits, -jnp.inf)
        p = jax.nn.softmax(logits, axis=-1).astype(v.dtype)
        o = jnp.einsum('btkgn,btnkd->btkgd', p, v_sel)
        return o.reshape(B, qb, N_HEADS * HEAD_DIM)

    out = lax.map(one_block, (blocks(q), blocks(q_idx), blocks(w_idx), q_pos.reshape(nb, qb)))
    return jnp.moveaxis(out, 0, 1).reshape(B, T, N_HEADS * HEAD_DIM)


def trunk_layer(x, pos, k_past, v_past, idxk_past, conv_prev,
                ffn1_norm, ffn1_w_gate, ffn1_w_up, ffn1_w_down,
                mix_norm, w_in, conv_w, q_norm, k_norm, idx_k_norm, w_out,
                ffn2_norm, ffn2_w_gate, ffn2_w_up, ffn2_w_down):
    B, T, _ = x.shape
    x = x + 0.5 * swiglu(rmsnorm(x, ffn1_norm), ffn1_w_gate, ffn1_w_up, ffn1_w_down)
    h = rmsnorm(x, mix_norm)
    z = h @ w_in
    gb, gc, xv, q, k, v, qi, ki, wi = jnp.split(z, SPLIT_POINTS, axis=-1)
    u = gc * xv
    up = jnp.concatenate([conv_prev.astype(u.dtype), u], axis=1)
    conv = sum(up[:, j:j + T] * conv_w[j] for j in range(CONV_W))
    conv_out = gb * conv
    conv_state = up[:, up.shape[1] - (CONV_W - 1):]
    q = rope_partial(rmsnorm(q.reshape(B, T, N_HEADS, HEAD_DIM), q_norm), pos, ROT_DIM)
    k = rope_partial(rmsnorm(k.reshape(B, T, N_KV_HEADS, HEAD_DIM), k_norm), pos, ROT_DIM)
    v = v.reshape(B, T, N_KV_HEADS, HEAD_DIM)
    qi = rope_partial(qi.reshape(B, T, N_IDX_HEADS, IDX_DIM), pos, IDX_ROT_DIM)
    ki = rope_partial(rmsnorm(ki, idx_k_norm)[:, :, None, :], pos, IDX_ROT_DIM)[:, :, 0]
    wi = wi * (N_IDX_HEADS ** -0.5)
    k_all = jnp.concatenate([k_past.astype(k.dtype), k], axis=1)
    v_all = jnp.concatenate([v_past.astype(v.dtype), v], axis=1)
    ki_all = jnp.concatenate([idxk_past.astype(ki.dtype), ki], axis=1)
    L = k_all.shape[1]
    n_sel = max(1, min(TOP_K, L // 4))
    attn = dsa_attention(q, qi, wi, k_all, v_all, ki_all, pos, n_sel)
    x = x + jnp.concatenate([conv_out, attn], axis=-1) @ w_out
    x = x + 0.5 * swiglu(rmsnorm(x, ffn2_norm), ffn2_w_gate, ffn2_w_up, ffn2_w_down)
    return x, k, v, ki, conv_state


def setup_inputs(seed: int = 0) -> dict:
    key = jax.random.key(seed)
    ks = jax.random.split(key, 24)
    f32 = jnp.float32
    nrm = lambda k, shape, s: jax.random.normal(k, shape, f32) * s
    gain = lambda k, n: 1.0 + nrm(k, (DEPTH, n), 0.02)
    return {
        'x_prompt': nrm(ks[0], (BATCH, SEQ, D_MODEL), 1.0),
        'x_sample': nrm(ks[1], (DEC_BATCH, DEC_SEQ, D_MODEL), 1.0),
        'cache_k': nrm(ks[2], (DEPTH, DEC_BATCH, PAST_LEN, N_KV_HEADS, HEAD_DIM), 1.0),
        'cache_v': nrm(ks[3], (DEPTH, DEC_BATCH, PAST_LEN, N_KV_HEADS, HEAD_DIM), 1.0),
        'cache_idx_k': nrm(ks[4], (DEPTH, DEC_BATCH, PAST_LEN, IDX_DIM), 1.0),
        'state_conv': nrm(ks[5], (DEPTH, DEC_BATCH, CONV_W - 1, D_CONV), 0.5),
        'ffn1_norm': gain(ks[6], D_MODEL),
        'ffn1_w_gate': nrm(ks[7], (DEPTH, D_MODEL, D_FF), D_MODEL ** -0.5),
        'ffn1_w_up': nrm(ks[8], (DEPTH, D_MODEL, D_FF), D_MODEL ** -0.5),
        'ffn1_w_down': nrm(ks[9], (DEPTH, D_FF, D_MODEL), D_FF ** -0.5),
        'mix_norm': gain(ks[10], D_MODEL),
        'w_in': nrm(ks[11], (DEPTH, D_MODEL, D_IN), D_MODEL ** -0.5),
        'conv_w': nrm(ks[12], (DEPTH, CONV_W, D_CONV), CONV_W ** -0.5),
        'q_norm': gain(ks[13], HEAD_DIM),
        'k_norm': gain(ks[14], HEAD_DIM),
        'idx_k_norm': gain(ks[15], IDX_DIM),
        'w_out': nrm(ks[16], (DEPTH, D_MIX, D_MODEL), D_MIX ** -0.5),
        'ffn2_norm': gain(ks[17], D_MODEL),
        'ffn2_w_gate': nrm(ks[18], (DEPTH, D_MODEL, D_FF), D_MODEL ** -0.5),
        'ffn2_w_up': nrm(ks[19], (DEPTH, D_MODEL, D_FF), D_MODEL ** -0.5),
        'ffn2_w_down': nrm(ks[20], (DEPTH, D_FF, D_MODEL), D_FF ** -0.5),
    }


def reference(x_prompt, x_sample, cache_k, cache_v, cache_idx_k, state_conv,
              ffn1_norm, ffn1_w_gate, ffn1_w_up, ffn1_w_down,
              mix_norm, w_in, conv_w, q_norm, k_norm, idx_k_norm, w_out,
              ffn2_norm, ffn2_w_gate, ffn2_w_up, ffn2_w_down):
    Bp, Tp = x_prompt.shape[0], x_prompt.shape[1]
    Bs, Ts = x_sample.shape[0], x_sample.shape[1]
    past = cache_k.shape[2]
    pos_p = jnp.arange(Tp)
    pos_s = past + jnp.arange(Ts)
    dt = x_prompt.dtype
    empty_kv = jnp.zeros((Bp, 0, N_KV_HEADS, HEAD_DIM), dt)
    empty_ik = jnp.zeros((Bp, 0, IDX_DIM), dt)
    zero_conv = jnp.zeros((Bp, CONV_W - 1, D_CONV), dt)
    hp, hs = x_prompt, x_sample
    kp_l, vp_l, ip_l, cp_l, ks_l, vs_l, is_l, cs_l = [], [], [], [], [], [], [], []
    for l in range(DEPTH):
        w = (ffn1_norm[l], ffn1_w_gate[l], ffn1_w_up[l], ffn1_w_down[l],
             mix_norm[l], w_in[l], conv_w[l], q_norm[l], k_norm[l], idx_k_norm[l], w_out[l],
             ffn2_norm[l], ffn2_w_gate[l], ffn2_w_up[l], ffn2_w_down[l])
        hp, kp, vp, ip, cp = trunk_layer(hp, pos_p, empty_kv, empty_kv, empty_ik, zero_conv, *w)
        hs, ks_, vs, is_, cs = trunk_layer(hs, pos_s, cache_k[l], cache_v[l], cache_idx_k[l], state_conv[l], *w)
        kp_l.append(kp); vp_l.append(vp); ip_l.append(ip); cp_l.append(cp)
        ks_l.append(ks_); vs_l.append(vs); is_l.append(is_); cs_l.append(cs)
    k_prompt = jnp.stack(kp_l); v_prompt = jnp.stack(vp_l)
    idx_k_prompt = jnp.stack(ip_l); conv_prompt = jnp.stack(cp_l)
    k_sample = jnp.stack(ks_l); v_sample = jnp.stack(vs_l)
    idx_k_sample = jnp.stack(is_l); conv_sample = jnp.stack(cs_l)
    return (hp, hs, k_prompt, v_prompt, idx_k_prompt, conv_prompt, k_sample, v_sample, idx_k_sample, conv_sample)
```

```cpp
#include <hip/hip_runtime.h>
#include <cstdio>
#include <cstdint>
#ifndef CONV_TAIL
#define CONV_TAIL 1
#endif
#ifndef REPEAT_MASK
#define REPEAT_MASK 0
#endif

namespace pg8 {
#define PG8_LAS __attribute__((address_space(3)))
typedef unsigned short bf16_t;
typedef short bf16x8 __attribute__((ext_vector_type(8)));
typedef float f32x4 __attribute__((ext_vector_type(4)));
typedef unsigned u32x4 __attribute__((ext_vector_type(4)));
constexpr int BM = 256, BK = 64, HALF = 128, HTB = HALF * BK * 2, STAGE_BYTES = 8 * HTB, NXCD = 8, WGM = 8;

__host__ __device__ __forceinline__ int lds_byte(int r, int c) { const int st = (r >> 4) * 2 + (c >> 5), rr = r & 15, cc = c & 31, ob = rr * 64 + cc * 2; return st * 1024 + (ob ^ (((ob >> 9) & 1) << 5)); }
__host__ __device__ __forceinline__ void stage_rc(int b, int& R, int& C) { const int st = b / 1024, sb = b % 1024, swz = sb ^ (((sb >> 9) & 1) << 5); R = (st >> 1) * 16 + swz / 64; C = (st & 1) * 32 + (swz % 64) / 2; }
__host__ __device__ __forceinline__ int perm32(int rho) { const int n = rho >> 4, i = rho & 15; return 8 * (i >> 2) + 4 * n + (i & 3); }

struct Unit { int pm, pn; };
struct Gemm { const bf16_t* A; const bf16_t* Bt; int M, N, K; };

struct StaticOrder {
    int nM, nN, nwg, G, c;
    __host__ __device__ void init(int M, int N, int G_, int c_) { nM = M / BM; nN = N / BM; nwg = nM * nN; G = G_; c = c_; }
    __host__ __device__ bool next(int i, Unit& u) const {
        const long L = (long)i * G + c; if (L >= nwg) return false;
        int wgid = (int)L; { const int q = nwg / NXCD, r = nwg % NXCD, xcd = wgid % NXCD, off = wgid / NXCD; wgid = (xcd < r ? xcd * (q + 1) : r * (q + 1) + (xcd - r) * q) + off; }
        const int nig = WGM * nN, gid = wgid / nig, fm = gid * WGM, gsz = (nM - fm) < WGM ? (nM - fm) : WGM;
        u.pm = fm + ((wgid % nig) % gsz); u.pn = (wgid % nig) / gsz; return true;
    }
    __device__ __forceinline__ void a_ready(const Unit&) const {}
    __device__ __forceinline__ void done(const Unit&) const {}
};

__device__ __forceinline__ unsigned cvt_pk_bf16(float lo, float hi) { unsigned r; asm volatile("v_cvt_pk_bf16_f32 %0, %1, %2" : "=v"(r) : "v"(lo), "v"(hi)); return r; }

typedef int i32x4 __attribute__((ext_vector_type(4)));
template <bool I8> __device__ __forceinline__ f32x4 mma16(const bf16x8 b, const bf16x8 a, const f32x4 c) {
    if constexpr (I8) return (f32x4)__builtin_amdgcn_mfma_i32_16x16x64_i8((i32x4)b, (i32x4)a, (i32x4)c, 0, 0, 0);
    else return __builtin_amdgcn_mfma_f32_16x16x32_bf16(b, a, c, 0, 0, 0);
}
typedef int i32x8 __attribute__((ext_vector_type(8)));
__device__ __forceinline__ f32x4 mma128(const i32x8 b8, const i32x8 a8, const f32x4 c) {
    return __builtin_amdgcn_mfma_scale_f32_16x16x128_f8f6f4(b8, a8, c, 0, 0, 0, 0, 0, 0);
}
__device__ __forceinline__ i32x8 ld8(const PG8_LAS unsigned char* p) {
    const i32x4 lo = *(const PG8_LAS i32x4*)p, hi = *(const PG8_LAS i32x4*)(p + 1024);
    return __builtin_shufflevector(lo, hi, 0, 1, 2, 3, 4, 5, 6, 7);
}
__device__ __forceinline__ const char* gptr32(const void* base, unsigned off) {
    const unsigned long long b = (unsigned long long)base; unsigned lo, hi;
    asm volatile("v_add_co_u32_e64 %0, vcc, %2, %3\n\tv_mov_b32 %1, %4\n\tv_addc_co_u32_e32 %1, vcc, 0, %1, vcc" : "=&v"(lo), "=&v"(hi) : "s"((unsigned)b), "v"(off), "s"((unsigned)(b >> 32)) : "vcc");
    return (const char*)(((unsigned long long)hi << 32) | lo);
}
template <class Epi, class Sched, bool ALIGN_EPI = false, bool SP2 = false, int MODE = 0>
__device__ __forceinline__ void gemm_phase(PG8_LAS unsigned char* lds, const Gemm g, const Sched S, const Epi E, const int wid  ) {
    int lane; asm volatile("v_mbcnt_lo_u32_b32 %0, -1, 0\n\tv_mbcnt_hi_u32_b32 %0, -1, %0" : "=v"(lane));
    const int tid = wid * 64 + lane, wr = wid >> 2, wc = wid & 3, fr = lane & 15, fq = lane >> 4;
    const int K = g.K, nt = K / BK;
    unsigned voffA[2], voffB[2];
#pragma unroll
    for (int i = 0; i < 2; ++i) { int R, C; stage_rc(tid * 16 + i * 8192, R, C); const int Rb = Epi::PERM ? ((R & ~31) + perm32(R & 31)) : R;
        voffA[i] = (unsigned)(R * K + C) * 2u; voffB[i] = (unsigned)(Rb * K + C) * 2u; }
    const size_t kstep = (size_t)(BK * 2);
    const size_t hstep = (size_t)HALF * K * 2;
    const size_t tstep = 2 * hstep;
    const unsigned ldsw = (unsigned)wid * 1024u;
    const int aoff = lds_byte(wr * 64 + fr, fq * 8), boff = lds_byte(wc * 32 + fr, fq * 8);
#define PG8_SA(b, h) (((b) * 2 + (h)) * HTB)
#define PG8_SB(b, h) ((4 + (b) * 2 + (h)) * HTB)
#define PG8_STAGE(bufoff, gbase, voff) do { _Pragma("unroll") for (int _i = 0; _i < 2; ++_i) { \
        if constexpr (MODE == 2) __builtin_amdgcn_global_load_lds((const unsigned*)gptr32((const char*)(gbase) + (size_t)_i * 128 * K, (voff)[0]), (PG8_LAS unsigned*)(lds + (bufoff) + ldsw + _i * 8192), 16, 0, 0);   \
        else __builtin_amdgcn_global_load_lds((const unsigned*)((const char*)(gbase) + (voff)[_i]), (PG8_LAS unsigned*)(lds + (bufoff) + ldsw + _i * 8192), 16, 0, 0); } } while (0)
#define PG8_MMAF(ai, bj, At, Bt) do { __builtin_amdgcn_s_setprio(1); _Pragma("unroll") for (int m = 0; m < 4; ++m) _Pragma("unroll") for (int n = 0; n < 2; ++n) \
        acc[ai][bj][m][n] = mma128(Bt##8[n], At##8[m], acc[ai][bj][m][n]); __builtin_amdgcn_s_setprio(0); } while (0)
#define PG8_MMA2(ai, At, b, h) do { if constexpr (MODE == 2) { PG8_MMAF(ai, 0, At, B0); PG8_MMAF(ai, 1, At, B1); } \
        else { PG8_MMA(ai, 0, At, B0); PG8_MMA(ai, 1, At, B1); } } while (0)
#define PG8_LDA(dst, b, h) do { if constexpr (MODE == 2) { _Pragma("unroll") for (int m = 0; m < 4; ++m) dst##8[m] = ld8(lds + PG8_SA(b, h) + aoff + m * 2048); } \
        else { _Pragma("unroll") for (int m = 0; m < 4; ++m) _Pragma("unroll") for (int k = 0; k < 2; ++k) dst[m][k] = *(const PG8_LAS bf16x8*)(lds + PG8_SA(b, h) + aoff + m * 2048 + k * 1024); } } while (0)
#define PG8_LDB(dst, b, h) do { if constexpr (MODE == 2) { _Pragma("unroll") for (int n = 0; n < 2; ++n) dst##8[n] = ld8(lds + PG8_SB(b, h) + boff + n * 2048); } \
        else { _Pragma("unroll") for (int n = 0; n < 2; ++n) _Pragma("unroll") for (int k = 0; k < 2; ++k) dst[n][k] = *(const PG8_LAS bf16x8*)(lds + PG8_SB(b, h) + boff + n * 2048 + k * 1024); } } while (0)
#define PG8_MMA(ai, bj, At, Bt) do { __builtin_amdgcn_s_setprio(1); _Pragma("unroll") for (int m = 0; m < 4; ++m) _Pragma("unroll") for (int n = 0; n < 2; ++n) { \
        if constexpr (MODE == 2) { static_assert(MODE != 2 || SP2, "fp8 mode: SP2 schedule only"); } \
        else { _Pragma("unroll") for (int k = 0; k < 2; ++k) acc[ai][bj][m][n] = mma16<MODE == 1>(Bt[n][k], At[m][k], acc[ai][bj][m][n]); } } __builtin_amdgcn_s_setprio(0); } while (0)
#define PG8_WAIT_V(n) asm volatile("s_waitcnt vmcnt(" #n ")" ::: "memory")
#define PG8_WAIT_L(n) asm volatile("s_waitcnt lgkmcnt(" #n ")" ::: "memory")
#define PG8_BAR __builtin_amdgcn_s_barrier()
#define PG8_SCHED __builtin_amdgcn_sched_barrier(0)
    Unit cur, nxt; int ui = 0;
    if (!S.next(0, cur)) return;
    f32x4 acc[2][2][4][2];
#pragma unroll
    for (int a = 0; a < 2; ++a)
#pragma unroll
        for (int b = 0; b < 2; ++b)
#pragma unroll
            for (int m = 0; m < 4; ++m)
#pragma unroll
                for (int n = 0; n < 2; ++n) acc[a][b][m][n] = (f32x4){0.f, 0.f, 0.f, 0.f};
    bf16x8 At[4][2], B0[2][2], B1[2][2];
    i32x8 At8[4], B08[2], B18[2];
    const char* cA = (const char*)g.A + (size_t)cur.pm * tstep; const char* cB = (const char*)g.Bt + (size_t)cur.pn * tstep;
    S.a_ready(cur);
    typename Epi::Pre pre;
    if constexpr (Epi::PREF) pre = E.prefetch(cur, wr, wc, fr, fq);
    if constexpr (SP2) {
        PG8_STAGE(PG8_SB(0, 0), cB, voffB); PG8_STAGE(PG8_SB(0, 1), cB + hstep, voffB); PG8_STAGE(PG8_SA(0, 0), cA, voffA); PG8_STAGE(PG8_SA(0, 1), cA + hstep, voffA);
        if (wr == 1) PG8_BAR;
        PG8_WAIT_V(2); PG8_BAR;
        PG8_STAGE(PG8_SB(1, 0), cB + kstep, voffB); PG8_STAGE(PG8_SA(1, 0), cA + kstep, voffA); PG8_STAGE(PG8_SB(1, 1), cB + hstep + kstep, voffB);
        PG8_WAIT_V(6); PG8_BAR;
    } else {
        PG8_STAGE(PG8_SB(0, 0), cB, voffB); PG8_STAGE(PG8_SA(0, 0), cA, voffA); PG8_STAGE(PG8_SB(0, 1), cB + hstep, voffB); PG8_STAGE(PG8_SA(0, 1), cA + hstep, voffA);
        if (wr == 1) PG8_BAR;
        PG8_WAIT_V(4); PG8_BAR;
        PG8_STAGE(PG8_SB(1, 0), cB + kstep, voffB); PG8_STAGE(PG8_SA(1, 0), cA + kstep, voffA); PG8_STAGE(PG8_SB(1, 1), cB + hstep + kstep, voffB);
        PG8_WAIT_V(6); PG8_BAR;
    }
    for (;;) {
        const bool has_next = S.next(ui + 1, nxt);
        const char* nA = has_next ? (const char*)g.A + (size_t)nxt.pm * tstep : cA; const char* nB = has_next ? (const char*)g.Bt + (size_t)nxt.pn * tstep : cB;
        for (int t = 0; t < nt; t += 2) {
            const bool last = (t == nt - 2);
            const char* a1 = cA + (size_t)(t + 1) * kstep;
            const char* a2 = last ? nA : cA + (size_t)(t + 2) * kstep; const char* b2 = last ? nB : cB + (size_t)(t + 2) * kstep;
            const char* a3 = a2 + kstep; const char* b3 = b2 + kstep;
            if (last && has_next) S.a_ready(nxt);
            if constexpr (SP2) {
            PG8_LDB(B0, 0, 0); PG8_LDB(B1, 0, 1); PG8_SCHED; PG8_LDA(At, 0, 0); PG8_STAGE(PG8_SA(1, 1), a1 + hstep, voffA);
            PG8_WAIT_V(8); PG8_WAIT_L(0); PG8_BAR; PG8_MMA2(0, At, 0, 0); PG8_BAR; PG8_SCHED;
            PG8_LDA(At, 0, 1); PG8_STAGE(PG8_SB(0, 0), b2, voffB); PG8_STAGE(PG8_SB(0, 1), b2 + hstep, voffB); PG8_STAGE(PG8_SA(0, 0), a2, voffA);
            PG8_WAIT_V(8); PG8_WAIT_L(0); PG8_BAR; PG8_MMA2(1, At, 0, 1); PG8_BAR; PG8_SCHED;
            PG8_LDB(B0, 1, 0); PG8_LDB(B1, 1, 1); PG8_SCHED; PG8_LDA(At, 1, 0); PG8_STAGE(PG8_SA(0, 1), a2 + hstep, voffA);
            PG8_WAIT_V(8); PG8_WAIT_L(0); PG8_BAR; PG8_MMA2(0, At, 1, 0); PG8_BAR; PG8_SCHED;
            PG8_LDA(At, 1, 1); PG8_STAGE(PG8_SB(1, 0), b3, voffB); PG8_STAGE(PG8_SB(1, 1), b3 + hstep, voffB); PG8_STAGE(PG8_SA(1, 0), a3, voffA);
            PG8_WAIT_V(8); PG8_WAIT_L(0); PG8_BAR; PG8_MMA2(1, At, 1, 1); PG8_BAR; PG8_SCHED;
            } else {
            PG8_LDB(B0, 0, 0); PG8_SCHED; PG8_LDA(At, 0, 0); PG8_STAGE(PG8_SA(1, 1), a1 + hstep, voffA);
            PG8_WAIT_L(8); PG8_BAR; PG8_WAIT_L(0); PG8_MMA(0, 0, At, B0); PG8_BAR; PG8_SCHED;
            PG8_LDB(B1, 0, 1); PG8_STAGE(PG8_SB(0, 0), b2, voffB);
            PG8_BAR; PG8_WAIT_L(0); PG8_MMA(0, 1, At, B1); PG8_BAR;
            PG8_LDA(At, 0, 1); PG8_STAGE(PG8_SA(0, 0), a2, voffA);
            PG8_BAR; PG8_WAIT_L(0); PG8_MMA(1, 0, At, B0); PG8_BAR; PG8_SCHED;
            PG8_STAGE(PG8_SB(0, 1), b2 + hstep, voffB);
            PG8_WAIT_V(6); PG8_BAR; PG8_MMA(1, 1, At, B1); PG8_BAR;
            PG8_LDB(B0, 1, 0); PG8_SCHED; PG8_LDA(At, 1, 0); PG8_STAGE(PG8_SA(0, 1), a2 + hstep, voffA);
            PG8_WAIT_L(8); PG8_BAR; PG8_WAIT_L(0); PG8_MMA(0, 0, At, B0); PG8_BAR; PG8_SCHED;
            PG8_LDB(B1, 1, 1); PG8_STAGE(PG8_SB(1, 0), b3, voffB);
            PG8_BAR; PG8_WAIT_L(0); PG8_MMA(0, 1, At, B1); PG8_BAR;
            PG8_LDA(At, 1, 1); PG8_STAGE(PG8_SA(1, 0), a3, voffA);
            PG8_BAR; PG8_WAIT_L(0); PG8_MMA(1, 0, At, B0); PG8_BAR; PG8_SCHED;
            PG8_STAGE(PG8_SB(1, 1), b3 + hstep, voffB);
            PG8_WAIT_V(6); PG8_BAR; PG8_MMA(1, 1, At, B1); PG8_BAR;
            }
        }
        if constexpr (ALIGN_EPI) { if (wr == 0) PG8_BAR; }
        if constexpr (!Epi::AFTER_DRAIN) {
            if constexpr (MODE == 2) {
                int l2; asm volatile("v_mbcnt_lo_u32_b32 %0, -1, 0\n\tv_mbcnt_hi_u32_b32 %0, -1, %0" : "=v"(l2));
                E(acc, cur, wr, wc, l2 & 15, l2 >> 4);
            } else if constexpr (Epi::PREF) E(acc, cur, wr, wc, fr, fq, pre);
            else E(acc, cur, wr, wc, fr, fq);
            S.done(cur); }
        if (!has_next) break;
#pragma unroll
        for (int a = 0; a < 2; ++a)
#pragma unroll
            for (int b = 0; b < 2; ++b)
#pragma unroll
                for (int m = 0; m < 4; ++m)
#pragma unroll
                    for (int n = 0; n < 2; ++n) acc[a][b][m][n] = (f32x4){0.f, 0.f, 0.f, 0.f};
        cur = nxt; cA = nA; cB = nB; ++ui;
        if constexpr (Epi::PREF) pre = E.prefetch(cur, wr, wc, fr, fq);
        if constexpr (ALIGN_EPI) { if (wr == 1) PG8_BAR; }
    }
    PG8_WAIT_V(0);
    if constexpr (!ALIGN_EPI) { if (wr == 0) PG8_BAR; }
    PG8_BAR;
#undef PG8_SA
#undef PG8_SB
#undef PG8_STAGE
#undef PG8_LDA
#undef PG8_LDB
#undef PG8_MMA
#undef PG8_MMA2
#undef PG8_MMAF
#undef PG8_WAIT_V
#undef PG8_WAIT_L
#undef PG8_BAR
#undef PG8_SCHED
}
}

typedef unsigned short bf16_t;
typedef short bf16x8 __attribute__((ext_vector_type(8)));
typedef float f32x4 __attribute__((ext_vector_type(4)));
typedef float f32x16 __attribute__((ext_vector_type(16)));
typedef unsigned u32x4 __attribute__((ext_vector_type(4)));
typedef unsigned u32x2 __attribute__((ext_vector_type(2)));
#define LAS __attribute__((address_space(3)))

constexpr int DM = 1024, TP = 2048, MP = 16384, TSQ = 16, MS = 128, MT = MP + MS;
constexpr int PAST = 1024, LSK = PAST + TSQ  , LSP = 1056;
constexpr int DFF = 2816, NFF2 = 5632, DIN = 2888, NZ = 3072, ZS = 2944;
constexpr int C_GB = 0, C_GC = 512, C_XV = 1024, C_Q = 1536, C_K = 2048, C_V = 2176, C_QI = 2304, C_KI = 2816;
constexpr float EPS = 1e-6f;
constexpr float QSCALE = 0.125f * 1.4426950408889634f;
constexpr float WISCALE = 0.35355339059327373f;

constexpr size_t O_Y = 0;
constexpr size_t O_KP = (size_t)MT * DM;
constexpr size_t O_VP = O_KP + (size_t)MP * 128;
constexpr size_t O_IP = O_VP + (size_t)MP * 128;
constexpr size_t O_CP = O_IP + (size_t)MP * 64;
constexpr size_t O_KS = O_CP + 8 * 2 * 512;
constexpr size_t O_VS = O_KS + (size_t)MS * 128;
constexpr size_t O_IS = O_VS + (size_t)MS * 128;
constexpr size_t O_CS = O_IS + (size_t)MS * 64;
constexpr size_t O_END = O_CS + 8 * 2 * 512;

constexpr size_t WS_CTL = 0;
constexpr size_t CTL_BYTES = 65536;
constexpr size_t WS_TAB = 65536;
constexpr size_t WS_W1Q = WS_TAB + 131072;
constexpr size_t WS_W2T = WS_W1Q + (size_t)NFF2 * DM;
constexpr size_t WS_W3T = WS_W2T + (size_t)DM * DFF * 2;
constexpr size_t WS_W4T = WS_W3T + (size_t)NZ * DM * 2;
constexpr size_t WS_W5Q = WS_W4T + (size_t)DM * DM * 2;
constexpr size_t WS_W6T = WS_W5Q + (size_t)NFF2 * DM;
constexpr size_t WS_AB = WS_W6T + (size_t)DM * DFF * 2;
constexpr size_t WS_R1 = WS_AB + (size_t)MT * DM * 2;
constexpr size_t WS_ZL = WS_R1 + (size_t)MT * ZS * 2;
constexpr size_t WS_A4 = WS_ZL + (size_t)MT * 128 * 4;
constexpr size_t WS_WIF = WS_A4 + (size_t)MT * DM * 2;
constexpr size_t WS_KP = WS_WIF + (size_t)MT * 8 * 4;
constexpr size_t WS_VTP = WS_KP + (size_t)8 * 2 * 2048 * 64 * 2;
constexpr size_t WS_KIP = WS_VTP + (size_t)8 * 2 * 2048 * 64 * 2;
constexpr size_t WS_KS = WS_KIP + (size_t)8 * 2048 * 64 * 2;
constexpr size_t WS_VTS = WS_KS + (size_t)8 * 2 * LSP * 64 * 2;
constexpr size_t WS_KIS = WS_VTS + (size_t)8 * 2 * LSP * 64 * 2;
constexpr size_t WS_PA = WS_KIS + (size_t)8 * LSP * 64 * 2;
constexpr size_t WS_PB = WS_PA + (size_t)MT * 16 * 4;
constexpr size_t WS_PC = WS_PB + (size_t)MT * 16 * 4;
constexpr size_t WS_PSB = WS_PC + (size_t)MT * 16 * 4;
constexpr size_t WS_PSC = WS_PSB + 128 * 64 * 4;
constexpr size_t WS_QIB = WS_PSC + 128 * 64 * 4;
constexpr size_t WS_XQ = WS_QIB + (size_t)MT * 512 * 2;
constexpr size_t WS_SB1 = WS_XQ + (size_t)MT * DM;
constexpr size_t WS_SB5 = WS_SB1 + (size_t)NFF2 * 4;
constexpr size_t WS_RM1 = WS_SB5 + (size_t)NFF2 * 4;
constexpr size_t WS_RM2 = WS_RM1 + (size_t)MT * 4;
constexpr size_t WS_SB6 = WS_RM2 + (size_t)MT * 4;
constexpr size_t WS_END = WS_SB6 + (size_t)DM * 4;
constexpr size_t WS_W6F = WS_W6T;
constexpr size_t WS_GB = WS_R1;
constexpr size_t WS_UB = WS_R1 + (size_t)MP * 512 * 2;
static_assert((size_t)MP * 512 * 2 * 2 <= (size_t)MP * ZS * 2, "GB/U below the sample z rows");
constexpr size_t WS_QB = WS_XQ;
static_assert((size_t)MT * 512 * 2 <= (size_t)MT * DM, "QB overlay");
static_assert(WS_END <= 268435456, "workspace map exceeds 256 MiB");
constexpr int CW_QUEUE = 64;

constexpr int LDS_BYTES = 155648;
constexpr int HIST_OFF = 141312;
constexpr int LDS_MISC = 140288;
constexpr int NWAVES = 8;

struct Args { const float* in[21]; float* out; unsigned char* ws; int ph_lo, ph_hi, coop, pad; };

__device__ __forceinline__ int lane_now() { int l; asm volatile("v_mbcnt_lo_u32_b32 %0, -1, 0\n\tv_mbcnt_hi_u32_b32 %0, -1, %0" : "=v"(l)); return l; }
__device__ __forceinline__ unsigned f2bf(float f) { unsigned u = __builtin_bit_cast(unsigned, f); return (u + 0x7fffu + ((u >> 16) & 1u)) >> 16; }
__device__ __forceinline__ unsigned pk2(float lo, float hi) { return pg8::cvt_pk_bf16(lo, hi); }
__device__ __forceinline__ float bf2f(unsigned short b) { return __builtin_bit_cast(float, (unsigned)b << 16); }
__device__ __forceinline__ float wave_sum(float v) {
#pragma unroll
    for (int o = 1; o < 64; o <<= 1) v += __shfl_xor(v, o);
    return v;
}
__device__ __forceinline__ float silu_f(float x) { return x * __builtin_amdgcn_rcpf(1.0f + __builtin_amdgcn_exp2f(-1.4426950408889634f * x)); }
__device__ __forceinline__ float rstd_from16(const float* p) {
    const f32x4 a = *(const f32x4*)p, b = *(const f32x4*)(p + 4), c = *(const f32x4*)(p + 8), d = *(const f32x4*)(p + 12);
    const float s = ((a[0] + a[1]) + (a[2] + a[3])) + ((b[0] + b[1]) + (b[2] + b[3])) + ((c[0] + c[1]) + (c[2] + c[3])) + ((d[0] + d[1]) + (d[2] + d[3]));
    return __builtin_amdgcn_rsqf(s * (1.0f / DM) + EPS);
}

struct EpiSwiGLU {
    static constexpr bool PERM = true, AFTER_DRAIN = false, PREF = false; struct Pre {};
    bf16_t* H; const float* part;
    __device__ __forceinline__ void operator()(const f32x4 (&acc)[2][2][4][2], const pg8::Unit& u, int wr, int wc, int fr, int fq) const {
        const int row0 = u.pm * 256 + wr * 64 + fr, col0 = u.pn * 128 + wc * 32 + 8 * fq;
#pragma unroll
        for (int ai = 0; ai < 2; ++ai)
#pragma unroll
            for (int m = 0; m < 4; ++m) {
                const int row = row0 + ai * 128 + m * 16;
                const float rs = rstd_from16(part + (size_t)row * 16);
                const f32x4 g0 = acc[ai][0][m][0] * rs, g1 = acc[ai][0][m][1] * rs, u0 = acc[ai][1][m][0] * rs, u1 = acc[ai][1][m][1] * rs;
                u32x4 w;
                w.x = pk2(silu_f(g0[0]) * u0[0], silu_f(g0[1]) * u0[1]); w.y = pk2(silu_f(g0[2]) * u0[2], silu_f(g0[3]) * u0[3]);
                w.z = pk2(silu_f(g1[0]) * u1[0], silu_f(g1[1]) * u1[1]); w.w = pk2(silu_f(g1[2]) * u1[2], silu_f(g1[3]) * u1[3]);
                *(u32x4*)(H + (size_t)row * DFF + col0) = w;
            }
    }
};
__device__ __forceinline__ f32x4 i2f4(const f32x4 a) { const pg8::i32x4 i = (pg8::i32x4)a; return (f32x4){(float)i[0], (float)i[1], (float)i[2], (float)i[3]}; }
__device__ __forceinline__ unsigned f8x4(float a, float b, float c, float d) { int w = 0; w = __builtin_amdgcn_cvt_pk_fp8_f32(a, b, w, false); w = __builtin_amdgcn_cvt_pk_fp8_f32(c, d, w, true); return (unsigned)w; }
template <bool F8OUT = false>
struct EpiSwiGLUQ {
    static constexpr bool PERM = true, AFTER_DRAIN = false, PREF = true;
    bf16_t* H; const float* rm; const float* cs;
    struct Pre { f32x4 cg0, cg1, cu0, cu1; float r[2][4]; };
    __device__ __forceinline__ Pre prefetch(const pg8::Unit& u, int wr, int wc, int fr, int fq) const {
        const int row0 = u.pm * 256 + wr * 64 + fr, crow = u.pn * 256 + wc * 32 + 8 * fq;
        Pre p; p.cg0 = *(const f32x4*)(cs + crow); p.cg1 = *(const f32x4*)(cs + crow + 4); p.cu0 = *(const f32x4*)(cs + crow + 128); p.cu1 = *(const f32x4*)(cs + crow + 132);
#pragma unroll
        for (int ai = 0; ai < 2; ++ai)
#pragma unroll
            for (int m = 0; m < 4; ++m) p.r[ai][m] = rm[row0 + ai * 128 + m * 16];
        return p;
    }
    __device__ __forceinline__ void operator()(const f32x4 (&acc)[2][2][4][2], const pg8::Unit& u, int wr, int wc, int fr, int fq, const Pre& pre) const {
        const int row0 = u.pm * 256 + wr * 64 + fr, col0 = u.pn * 128 + wc * 32 + 8 * fq;
        typedef float f32x2 __attribute__((ext_vector_type(2)));
        const f32x4 cl0 = pre.cg0 * -1.4426950408889634f, cl1 = pre.cg1 * -1.4426950408889634f, cp0 = pre.cg0 * pre.cu0, cp1 = pre.cg1 * pre.cu1;
#pragma unroll
        for (int ai = 0; ai < 2; ++ai)
#pragma unroll
            for (int m = 0; m < 4; ++m) {
                const int row = row0 + ai * 128 + m * 16;
                const float r = pre.r[ai][m], r2 = r * r;
                float h[8];
#pragma unroll
                for (int n = 0; n < 2; ++n) {
                    const f32x4 fg = i2f4(acc[ai][0][m][n]), fu = i2f4(acc[ai][1][m][n]);
                    const f32x4 sl = (n ? cl1 : cl0) * r, sp = (n ? cp1 : cp0) * r2;
#pragma unroll
                    for (int e2 = 0; e2 < 2; ++e2) {
                        const f32x2 g2 = (f32x2){fg[2 * e2], fg[2 * e2 + 1]}, u2 = (f32x2){fu[2 * e2], fu[2 * e2 + 1]};
                        const f32x2 t = g2 * (f32x2){sl[2 * e2], sl[2 * e2 + 1]};
                        f32x2 d = (f32x2){__builtin_amdgcn_exp2f(t.x), __builtin_amdgcn_exp2f(t.y)} + 1.0f;
                        const f32x2 rc = (f32x2){__builtin_amdgcn_rcpf(d.x), __builtin_amdgcn_rcpf(d.y)};
                        const f32x2 o = ((g2 * u2) * (f32x2){sp[2 * e2], sp[2 * e2 + 1]}) * rc;
                        h[4 * n + 2 * e2] = o.x; h[4 * n + 2 * e2 + 1] = o.y;
                    }
                }
                if constexpr (F8OUT) {
                    u32x2 w; w.x = f8x4(h[0], h[1], h[2], h[3]); w.y = f8x4(h[4], h[5], h[6], h[7]);
                    *(u32x2*)((unsigned char*)H + (size_t)row * DFF + col0) = w;
                } else {
                    u32x4 w; w.x = pk2(h[0], h[1]); w.y = pk2(h[2], h[3]); w.z = pk2(h[4], h[5]); w.w = pk2(h[6], h[7]);
                    *(u32x4*)(H + (size_t)row * DFF + col0) = w;
                }
            }
    }
};
template <int RIN, bool WOUT, bool WB, bool HALFC, bool CSC = false, bool WPART = true> struct EpiResid {
    static constexpr bool PERM = true, AFTER_DRAIN = false, PREF = false; struct Pre {};
    const float* resid; float* out; bf16_t* xb; float* part; const bf16_t* xbi;
    const float* cs;
    __device__ __forceinline__ void operator()(const f32x4 (&acc)[2][2][4][2], const pg8::Unit& u, int wr, int wc, int fr, int fq) const {
        const float coef = HALFC ? 0.5f : 1.0f;
        asm volatile("" : "+v"(fq), "+v"(fr));
        const int row0 = u.pm * 256 + wr * 64 + fr, col0 = u.pn * 256 + wc * 32 + 8 * fq;
        if constexpr (CSC) {
            f32x4 (&ma)[2][2][4][2] = const_cast<f32x4 (&)[2][2][4][2]>(acc);
#pragma unroll
            for (int bj = 0; bj < 2; ++bj) {
                const f32x4 c0 = *(const f32x4*)(cs + col0 + bj * 128), c1 = *(const f32x4*)(cs + col0 + bj * 128 + 4);
#pragma unroll
                for (int ai = 0; ai < 2; ++ai)
#pragma unroll
                    for (int m = 0; m < 4; ++m) { ma[ai][bj][m][0] = ma[ai][bj][m][0] * c0; ma[ai][bj][m][1] = ma[ai][bj][m][1] * c1; }
            }
        }
#pragma unroll
        for (int ai = 0; ai < 2; ++ai) {
            f32x4 rv[4][2][2];
#pragma unroll
            for (int m = 0; m < 4; ++m)
#pragma unroll
                for (int bj = 0; bj < 2; ++bj) {
                    const size_t off = (size_t)(row0 + ai * 128 + m * 16) * DM + col0 + bj * 128;
                    if (RIN == 0) { rv[m][bj][0] = *(const f32x4*)(resid + off); rv[m][bj][1] = *(const f32x4*)(resid + off + 4); }
                    else { const u32x4 w = *(const u32x4*)(xbi + off);
                        rv[m][bj][0] = (f32x4){__builtin_bit_cast(float, w.x << 16), __builtin_bit_cast(float, w.x & 0xffff0000u), __builtin_bit_cast(float, w.y << 16), __builtin_bit_cast(float, w.y & 0xffff0000u)};
                        rv[m][bj][1] = (f32x4){__builtin_bit_cast(float, w.z << 16), __builtin_bit_cast(float, w.z & 0xffff0000u), __builtin_bit_cast(float, w.w << 16), __builtin_bit_cast(float, w.w & 0xffff0000u)}; }
                }
#pragma unroll
            for (int m = 0; m < 4; ++m) {
                const int row = row0 + ai * 128 + m * 16; float ss = 0.f;
#pragma unroll
                for (int bj = 0; bj < 2; ++bj) {
                    const size_t off = (size_t)row * DM + col0 + bj * 128;
                    const f32x4 v0 = rv[m][bj][0] + acc[ai][bj][m][0] * coef, v1 = rv[m][bj][1] + acc[ai][bj][m][1] * coef;
                    if (WOUT) { *(f32x4*)(out + off) = v0; *(f32x4*)(out + off + 4) = v1; }
                    if (WB) {
                        u32x4 w; w.x = pk2(v0[0], v0[1]); w.y = pk2(v0[2], v0[3]); w.z = pk2(v1[0], v1[1]); w.w = pk2(v1[2], v1[3]);
                        *(u32x4*)(xb + off) = w;
                        if (WPART) ss += (v0[0] * v0[0] + v0[1] * v0[1]) + (v0[2] * v0[2] + v0[3] * v0[3]) + (v1[0] * v1[0] + v1[1] * v1[1]) + (v1[2] * v1[2] + v1[3] * v1[3]);
                    }
                }
                if (WB && WPART) { ss += __shfl_xor(ss, 16); ss += __shfl_xor(ss, 32); if (fq == 0) part[(size_t)row * 16 + u.pn * 4 + wc] = ss; }
            }
        }
    }
};
__host__ __device__ __forceinline__ int dmap_inv(int d) {
    if (d < 16) { const int r = d & 7, hi = d >> 3; return 8 * (r >> 1) + (r & 1) + 2 * hi; }
    if (d < 32) { const int dd = d - 16; return 8 * (dd >> 2) + 4 + (dd & 3); }
    const int dd = d - 32; return 128 + 8 * (dd >> 3) + 4 * ((dd >> 2) & 1) + (dd & 3);
}
__host__ __device__ __forceinline__ int dmap(int tcw) {
    const int bj = tcw >> 7, fq = (tcw >> 3) & 3, n = (tcw >> 2) & 1, e = tcw & 3;
    if (bj) return 32 + 8 * fq + 4 * n + e;
    if (n) return 16 + 4 * fq + e;
    return e < 2 ? 2 * fq + e : 2 * fq + 8 + (e - 2);
}
__host__ __device__ __forceinline__ int w3_dst(int c) {
    if (c < 512) return c;
    if (c < 1024) { const int cc = c - 512; return 256 * (2 + (cc >> 7)) + (cc & 127); }
    if (c < 1536) { const int cc = c - 1024; return 256 * (2 + (cc >> 7)) + 128 + (cc & 127); }
    if (c < 2048) { const int cc = c - 1536, h = cc >> 6; return 256 * (6 + (h >> 2)) + 32 * (h & 3) + dmap_inv(cc & 63); }
    if (c < 2176) { const int cc = c - 2048, kv = cc >> 6; return 256 * 8 + 32 * kv + dmap_inv(cc & 63); }
    if (c < 2304) { const int cc = c - 2176, kv = cc >> 6; return 256 * 8 + 32 * (2 + kv) + dmap_inv(cc & 63); }
    if (c < 2816) { const int cc = c - 2304, h = cc >> 6; return 256 * (9 + (h >> 2)) + 32 * (h & 3) + dmap_inv(cc & 63); }
    if (c < 2880) return 256 * 11 + dmap_inv(c - 2816);
    const int j = c - 2880; return 256 * 11 + 32 + 4 * (j >> 2) + (j & 3);
}
__host__ __device__ __forceinline__ int w3_src(int r) {
    const int pn = r >> 8, tc = r & 255, wc = (tc >> 5) & 3, tcw = tc & 0x9F;
    if (pn < 2) return r;
    if (pn < 6) return ((tc >> 7) ? 1024 : 512) + 128 * (pn - 2) + (tc & 127);
    if (pn < 8) return 1536 + 64 * (4 * (pn - 6) + wc) + dmap(tcw);
    if (pn == 8) return (wc < 2 ? 2048 + 64 * wc : 2176 + 64 * (wc - 2)) + dmap(tcw);
    if (pn < 11) return 2304 + 64 * (4 * (pn - 9) + wc) + dmap(tcw);
    if (wc == 0) return 2816 + dmap(tcw);
    if (wc == 1 && tcw < 8) return 2880 + tcw;
    return -1;
}
__device__ __forceinline__ size_t vt_index(int bk, int SL, int d, int s);

struct EpiZF {
    static constexpr bool PERM = true, AFTER_DRAIN = false, PREF = false; struct Pre {};
    unsigned char* ws; float* out; const float* part; const float* qn; const float* kn; const float* ikn;
    static __device__ __forceinline__ void head_xf(f32x4& x0, f32x4& x1, f32x4& x2, f32x4& x3, bool do_norm, const float* g, bool do_rope, const float* tab, int fq) {
        if (do_norm) {
            float ss = (x0[0] * x0[0] + x0[1] * x0[1]) + (x0[2] * x0[2] + x0[3] * x0[3]) + (x1[0] * x1[0] + x1[1] * x1[1]) + (x1[2] * x1[2] + x1[3] * x1[3])
                     + (x2[0] * x2[0] + x2[1] * x2[1]) + (x2[2] * x2[2] + x2[3] * x2[3]) + (x3[0] * x3[0] + x3[1] * x3[1]) + (x3[2] * x3[2] + x3[3] * x3[3]);
            ss += __shfl_xor(ss, 16); ss += __shfl_xor(ss, 32);
            const float rn = __builtin_amdgcn_rsqf(ss * (1.0f / 64.0f) + EPS);
            const float ga0 = g[2 * fq], ga1 = g[2 * fq + 1], ga2 = g[2 * fq + 8], ga3 = g[2 * fq + 9];
            const f32x4 g1 = *(const f32x4*)(g + 16 + 4 * fq), g2 = *(const f32x4*)(g + 32 + 8 * fq), g3 = *(const f32x4*)(g + 36 + 8 * fq);
            x0 = (f32x4){x0[0] * rn * ga0, x0[1] * rn * ga1, x0[2] * rn * ga2, x0[3] * rn * ga3};
            x1 = x1 * rn * g1; x2 = x2 * rn * g2; x3 = x3 * rn * g3;
        }
        if (do_rope) {
            const float c0 = tab[2 * fq], c1 = tab[2 * fq + 1], s0 = tab[8 + 2 * fq], s1 = tab[8 + 2 * fq + 1];
            const float y0 = x0[0], y1 = x0[1], y2 = x0[2], y3 = x0[3];
            x0 = (f32x4){y0 * c0 - y2 * s0, y1 * c1 - y3 * s1, y0 * s0 + y2 * c0, y1 * s1 + y3 * c1};
        }
    }
    static __device__ __forceinline__ void st_head_bf16(bf16_t* p  , const f32x4& x0, const f32x4& x1, const f32x4& x2, const f32x4& x3, int fq) {
        *(unsigned*)(p + 2 * fq) = pk2(x0[0], x0[1]); *(unsigned*)(p + 2 * fq + 8) = pk2(x0[2], x0[3]);
        u32x2 w1; w1.x = pk2(x1[0], x1[1]); w1.y = pk2(x1[2], x1[3]); *(u32x2*)(p + 16 + 4 * fq) = w1;
        u32x4 w2; w2.x = pk2(x2[0], x2[1]); w2.y = pk2(x2[2], x2[3]); w2.z = pk2(x3[0], x3[1]); w2.w = pk2(x3[2], x3[3]); *(u32x4*)(p + 32 + 8 * fq) = w2;
    }
    static __device__ __forceinline__ void st_head_f32(float* p, const f32x4& x0, const f32x4& x1, const f32x4& x2, const f32x4& x3, int fq) {
        typedef float f32x2_ __attribute__((ext_vector_type(2)));
        *(f32x2_*)(p + 2 * fq) = (f32x2_){x0[0], x0[1]}; *(f32x2_*)(p + 2 * fq + 8) = (f32x2_){x0[2], x0[3]};
        *(f32x4*)(p + 16 + 4 * fq) = x1; *(f32x4*)(p + 32 + 8 * fq) = x2; *(f32x4*)(p + 36 + 8 * fq) = x3;
    }
    __device__ __forceinline__ void operator()(const f32x4 (&acc)[2][2][4][2], const pg8::Unit& u, int wr, int wc, int fr, int fq) const {
        asm volatile("" : "+v"(fq), "+v"(fr));
        const int row0 = u.pm * 256 + wr * 64 + fr, pn = u.pn;
        bf16_t* const GBUF = (bf16_t*)(ws + WS_GB); bf16_t* const UBUF = (bf16_t*)(ws + WS_UB); bf16_t* const QB = (bf16_t*)(ws + WS_QB); bf16_t* const QIB = (bf16_t*)(ws + WS_QIB);
        float* const WIF = (float*)(ws + WS_WIF); bf16_t* const KP = (bf16_t*)(ws + WS_KP); bf16_t* const VTP = (bf16_t*)(ws + WS_VTP); bf16_t* const KIP = (bf16_t*)(ws + WS_KIP); const float* const TAB = (const float*)(ws + WS_TAB);
#pragma unroll
        for (int ai = 0; ai < 2; ++ai)
#pragma unroll
            for (int m = 0; m < 4; ++m) {
                const int row = row0 + ai * 128 + m * 16, b = row >> 11, t = row & (TP - 1);
                const float rs = rstd_from16(part + (size_t)row * 16);
                f32x4 x0 = acc[ai][0][m][0] * rs, x1 = acc[ai][0][m][1] * rs, x2 = acc[ai][1][m][0] * rs, x3 = acc[ai][1][m][1] * rs;
                if (pn < 2) {
                    const int c = 256 * pn + 32 * wc + 8 * fq;
                    u32x4 w; w.x = pk2(x0[0], x0[1]); w.y = pk2(x0[2], x0[3]); w.z = pk2(x1[0], x1[1]); w.w = pk2(x1[2], x1[3]); *(u32x4*)(GBUF + (size_t)row * 512 + c) = w;
                    w.x = pk2(x2[0], x2[1]); w.y = pk2(x2[2], x2[3]); w.z = pk2(x3[0], x3[1]); w.w = pk2(x3[2], x3[3]); *(u32x4*)(GBUF + (size_t)row * 512 + c + 128) = w;
                } else if (pn < 6) {
                    const int c = 128 * (pn - 2) + 32 * wc + 8 * fq;
                    const f32x4 u0 = x0 * x2, u1 = x1 * x3;
                    u32x4 w; w.x = pk2(u0[0], u0[1]); w.y = pk2(u0[2], u0[3]); w.z = pk2(u1[0], u1[1]); w.w = pk2(u1[2], u1[3]); *(u32x4*)(UBUF + (size_t)row * 512 + c) = w;
                    if (t >= TP - 2) { float* cp = out + O_CP + (size_t)(b * 2 + (t - (TP - 2))) * 512 + c; *(f32x4*)cp = u0; *(f32x4*)(cp + 4) = u1; }
                } else if (pn < 8) {
                    const int h = 4 * (pn - 6) + wc;
                    head_xf(x0, x1, x2, x3, true, qn, true, TAB + t * 16, fq);
                    x0 = x0 * QSCALE; x1 = x1 * QSCALE; x2 = x2 * QSCALE; x3 = x3 * QSCALE;
                    st_head_bf16(QB + (size_t)row * 512 + 64 * h, x0, x1, x2, x3, fq);
                } else if (pn == 8) {
                    if (wc < 2) {
                        head_xf(x0, x1, x2, x3, true, kn, true, TAB + t * 16, fq);
                        st_head_f32(out + O_KP + (size_t)row * 128 + 64 * wc, x0, x1, x2, x3, fq);
                        st_head_bf16(KP + ((size_t)(b * 2 + wc) * TP + t) * 64, x0, x1, x2, x3, fq);
                    } else {
                        const int kv = wc - 2;
                        st_head_f32(out + O_VP + (size_t)row * 128 + 64 * kv, x0, x1, x2, x3, fq);
                        bf16_t* vt = VTP + vt_index(b * 2 + kv, TP, 0, t);
                        vt[(2 * fq) * 32] = (bf16_t)f2bf(x0[0]); vt[(2 * fq + 1) * 32] = (bf16_t)f2bf(x0[1]); vt[(2 * fq + 8) * 32] = (bf16_t)f2bf(x0[2]); vt[(2 * fq + 9) * 32] = (bf16_t)f2bf(x0[3]);
#pragma unroll
                        for (int e = 0; e < 4; ++e) { vt[(16 + 4 * fq + e) * 32] = (bf16_t)f2bf(x1[e]); vt[(32 + 8 * fq + e) * 32] = (bf16_t)f2bf(x2[e]); vt[(36 + 8 * fq + e) * 32] = (bf16_t)f2bf(x3[e]); }
                    }
                } else if (pn < 11) {
                    const int h = 4 * (pn - 9) + wc;
                    head_xf(x0, x1, x2, x3, false, nullptr, true, TAB + t * 16, fq);
                    st_head_bf16(QIB + (size_t)row * 512 + 64 * h, x0, x1, x2, x3, fq);
                } else {
                    if (wc == 0) {
                        head_xf(x0, x1, x2, x3, true, ikn, true, TAB + t * 16, fq);
                        st_head_f32(out + O_IP + (size_t)row * 64, x0, x1, x2, x3, fq);
                        x0 = x0 * 0.125f; x1 = x1 * 0.125f; x2 = x2 * 0.125f; x3 = x3 * 0.125f;
                        st_head_bf16(KIP + ((size_t)b * TP + t) * 64, x0, x1, x2, x3, fq);
                    } else if (wc == 1) {
                        if (fq == 0) { float* wp = WIF + (size_t)row * 8; *(f32x4*)wp = x0 * WISCALE; *(f32x4*)(wp + 4) = x1 * WISCALE; }
                    }
                }
            }
    }
};

struct Order3 : pg8::StaticOrder {
    __device__ __forceinline__ bool next(int i, pg8::Unit& u) const { const bool ok = pg8::StaticOrder::next(i, u); u.pn = u.pn + 4 < 12 ? u.pn + 4 : u.pn - 8; return ok; }
};

template <int NB, int RB, bool I8 = false, int UNR = 2>
__device__ __forceinline__ void small_gemm_sk(const bf16_t* A  , int K, const bf16_t* B0, const bf16_t* B1, LAS unsigned char* lds, int wave, int lane, f32x4& o0, f32x4& o1) {
    const int kw = K >> 3;
    f32x4 acc[RB][NB];
#pragma unroll
    for (int rb = 0; rb < RB; ++rb)
#pragma unroll
        for (int nb = 0; nb < NB; ++nb) acc[rb][nb] = (f32x4){0.f, 0.f, 0.f, 0.f};
    const bf16_t* ap = A + (size_t)(lane & 15) * K + wave * kw + 8 * (lane >> 4);
    const bf16_t* b0 = B0 + (size_t)(lane & 15) * K + wave * kw + 8 * (lane >> 4);
    const bf16_t* b1 = B1 + (size_t)(lane & 15) * K + wave * kw + 8 * (lane >> 4);
#pragma unroll UNR
    for (int k0 = 0; k0 < kw; k0 += 32) {
        const bf16x8 x0 = *(const bf16x8*)(b0 + k0);
        bf16x8 x1 = x0;
        if (NB == 2) x1 = *(const bf16x8*)(b1 + k0);
#pragma unroll
        for (int rb = 0; rb < RB; ++rb) {
            const bf16x8 a = *(const bf16x8*)(ap + (size_t)rb * 16 * K + k0);
            acc[rb][0] = pg8::mma16<I8>(x0, a, acc[rb][0]);
            if (NB == 2) acc[rb][NB - 1] = pg8::mma16<I8>(x1, a, acc[rb][NB - 1]);
        }
    }
    LAS f32x4* P = (LAS f32x4*)lds;
    __syncthreads();
#pragma unroll
    for (int rb = 0; rb < RB; ++rb)
#pragma unroll
        for (int nb = 0; nb < NB; ++nb) P[((wave * RB + rb) * NB + nb) * 64 + lane] = acc[rb][nb];
    __syncthreads();
    f32x4 s0 = (f32x4){0.f, 0.f, 0.f, 0.f}, s1 = s0;
    if (wave < RB) {
        if constexpr (I8) {
            pg8::i32x4 t0 = (pg8::i32x4){0, 0, 0, 0}, t1 = t0;
#pragma unroll
            for (int w2 = 0; w2 < 8; ++w2) { t0 += (pg8::i32x4)P[((w2 * RB + wave) * NB + 0) * 64 + lane]; if (NB == 2) t1 += (pg8::i32x4)P[((w2 * RB + wave) * NB + (NB - 1)) * 64 + lane]; }
            s0 = (f32x4)t0; s1 = (f32x4)t1;
        } else {
#pragma unroll
            for (int w2 = 0; w2 < 8; ++w2) { s0 += P[((w2 * RB + wave) * NB + 0) * 64 + lane]; if (NB == 2) s1 += P[((w2 * RB + wave) * NB + (NB - 1)) * 64 + lane]; }
        }
    }
    o0 = s0; o1 = s1;
}
__device__ __forceinline__ float rstd_sample(const float* part, int np, int row) {
    float s = 0.f;
    for (int i = 0; i < np; i += 4) { const f32x4 a = *(const f32x4*)(part + (size_t)row * np + i); s += (a[0] + a[1]) + (a[2] + a[3]); }
    return __builtin_amdgcn_rsqf(s * (1.0f / DM) + EPS);
}
template <bool F8OUT = false>
__device__ __forceinline__ void sample_swiglu(const bf16_t* XQ, const bf16_t* WQ, bf16_t* H, const float* rm, const float* cs, int wg_lo, int nwg, int bid, LAS unsigned char* lds, int wave, int lane) {
    if (bid < wg_lo) return;
    const int tk = lane & 15, cq = lane >> 4, row = 16 * wave + tk;
    for (int it = bid - wg_lo; it < DFF / 16; it += nwg - wg_lo) {
        const int hc0 = 16 * it, grow = 256 * (hc0 >> 7) + (hc0 & 127);
        f32x4 g, u;
        small_gemm_sk<2, 8, true>(XQ + (size_t)MP * (DM / 2), DM / 2, WQ + (size_t)grow * (DM / 2), WQ + (size_t)(grow + 128) * (DM / 2), lds, wave, lane, g, u);
        const float r = rm[MP + row];
        g = i2f4(g) * (*(const f32x4*)(cs + grow + 4 * cq) * r); u = i2f4(u) * (*(const f32x4*)(cs + grow + 128 + 4 * cq) * r);
        if constexpr (F8OUT) *(unsigned*)((unsigned char*)H + (size_t)(MP + row) * DFF + hc0 + 4 * cq) = f8x4(silu_f(g[0]) * u[0], silu_f(g[1]) * u[1], silu_f(g[2]) * u[2], silu_f(g[3]) * u[3]);
        else { u32x2 w; w.x = pk2(silu_f(g[0]) * u[0], silu_f(g[1]) * u[1]); w.y = pk2(silu_f(g[2]) * u[2], silu_f(g[3]) * u[3]);
        *(u32x2*)(H + (size_t)(MP + row) * DFF + hc0 + 4 * cq) = w; }
    }
}
template <int RIN, bool WOUT, bool WB>
__device__ __forceinline__ void sample_resid(const bf16_t* A, int K, const bf16_t* W, const float* resid, float* out, float coef, bf16_t* xb, float* partS, int nwg, int bid, LAS unsigned char* lds, int wave, int lane) {
    const int tk = lane & 15, cq = lane >> 4;
    for (int it2 = bid; it2 < (DM / 16) * 4; it2 += nwg) {
        const int it = it2 >> 2, rq = it2 & 3;
        f32x4 a, dummy;
        small_gemm_sk<1, 2, false, 12>(A + (size_t)(32 * rq) * K, K, W + (size_t)(16 * it) * K, W, lds, wave, lane, a, dummy);
        if (wave < 2) {
            const int row = 32 * rq + 16 * wave + tk;
            const size_t off = (size_t)row * DM + 16 * it + 4 * cq;
            f32x4 r;
            if (RIN == 0) r = *(const f32x4*)(resid + off);
            else { const u32x2 w = *(const u32x2*)(xb + off); r = (f32x4){__builtin_bit_cast(float, w.x << 16), __builtin_bit_cast(float, w.x & 0xffff0000u), __builtin_bit_cast(float, w.y << 16), __builtin_bit_cast(float, w.y & 0xffff0000u)}; }
            const f32x4 v = r + a * coef;
            if (WOUT) *(f32x4*)(out + off) = v;
            if (WB) {
                u32x2 w; w.x = pk2(v[0], v[1]); w.y = pk2(v[2], v[3]); *(u32x2*)(xb + off) = w;
                if (partS) {
                    float ss = (v[0] * v[0] + v[1] * v[1]) + (v[2] * v[2] + v[3] * v[3]);
                    ss += __shfl_xor(ss, 16); ss += __shfl_xor(ss, 32);
                    if (cq == 0) partS[row * 64 + it] = ss;
                }
            }
        }
    }
}
__device__ __forceinline__ void sample_resid_f8(const unsigned char* A, const unsigned char* W, const float* cs, float* out, const bf16_t* xb, int nwg, int bid, LAS unsigned char* lds, int wave, int lane) {
    const int tk = lane & 15, cq = lane >> 4;
    constexpr int KB = DFF, KW = DFF / 8;
    for (int it2 = bid; it2 < (DM / 16) * 4; it2 += nwg) {
        const int it = it2 >> 2, rq = it2 & 3;
        f32x4 acc[2] = {(f32x4){0.f, 0.f, 0.f, 0.f}, (f32x4){0.f, 0.f, 0.f, 0.f}};
        const unsigned char* ap = A + (size_t)(32 * rq + tk) * KB + wave * KW + 8 * cq;
        const unsigned char* bp = W + (size_t)(16 * it + tk) * KB + wave * KW + 8 * cq;
#pragma unroll
        for (int k0 = 0; k0 < KW; k0 += 32) {
            const long x = *(const long*)(bp + k0);
#pragma unroll
            for (int rb = 0; rb < 2; ++rb) { const long a = *(const long*)(ap + (size_t)rb * 16 * KB + k0); acc[rb] = __builtin_amdgcn_mfma_f32_16x16x32_fp8_fp8(x, a, acc[rb], 0, 0, 0); }
        }
        LAS f32x4* P = (LAS f32x4*)lds;
        __syncthreads();
        P[(wave * 2 + 0) * 64 + lane] = acc[0]; P[(wave * 2 + 1) * 64 + lane] = acc[1];
        __syncthreads();
        if (wave < 2) {
            f32x4 a = (f32x4){0.f, 0.f, 0.f, 0.f};
#pragma unroll
            for (int w2 = 0; w2 < 8; ++w2) a += P[(w2 * 2 + wave) * 64 + lane];
            const int row = 32 * rq + 16 * wave + tk;
            const size_t off = (size_t)row * DM + 16 * it + 4 * cq;
            const u32x2 w = *(const u32x2*)(xb + off);
            const f32x4 r = (f32x4){__builtin_bit_cast(float, w.x << 16), __builtin_bit_cast(float, w.x & 0xffff0000u), __builtin_bit_cast(float, w.y << 16), __builtin_bit_cast(float, w.y & 0xffff0000u)};
            *(f32x4*)(out + off) = r + a * (*(const f32x4*)(cs + 16 * it + 4 * cq) * 0.5f);
        }
    }
}
__device__ __forceinline__ void sample_z(const bf16_t* AB, const bf16_t* W, bf16_t* Z, float* ZL, const float* partS, int nwg, int bid, LAS unsigned char* lds, int wave, int lane) {
    const int tk = lane & 15, cq = lane >> 4, row = 16 * wave + tk;
    for (int it = bid; it < NZ / 16; it += nwg) {
        f32x4 a, dummy;
        small_gemm_sk<1, 8>(AB + (size_t)MP * DM, DM, W + (size_t)(16 * it) * DM, W, lds, wave, lane, a, dummy);
        const float rs = rstd_sample(partS, 64, row);
        a = a * rs;
#pragma unroll
        for (int j = 0; j < 4; ++j) {
            const int c = w3_src(16 * it + 4 * cq + j);
            if (c >= 0) {
                Z[(size_t)(MP + row) * ZS + c] = (bf16_t)f2bf(a[j]);
                if (c >= C_KI) ZL[(size_t)(MP + row) * 128 + (c - C_KI)] = a[j];
            }
        }
    }
}

template <bool W3MODE = false>
__device__ __forceinline__ void p0_transpose_item(const float* W, int K, int N, const float* gain, bf16_t* WT, int drow0, int k0, int n0, LAS float* scr, int lane) {
    const int c4 = 4 * (lane & 7), n = n0 + c4;
    f32x4 v[8];
#pragma unroll
    for (int i = 0; i < 8; ++i) {
        const int kk = 8 * i + (lane >> 3);
        v[i] = (n < N) ? *(const f32x4*)(W + (size_t)(k0 + kk) * N + n) : (f32x4){0.f, 0.f, 0.f, 0.f};
    }
#pragma unroll
    for (int i = 0; i < 8; ++i) {
        const int kk = 8 * i + (lane >> 3);
        f32x4 x = v[i];
        if (gain) x = x * gain[k0 + kk];
        LAS float* d = scr + kk * 33 + c4;
        d[0] = x[0]; d[1] = x[1]; d[2] = x[2]; d[3] = x[3];
    }
    asm volatile("s_waitcnt lgkmcnt(0)" ::: "memory");
    const int c = lane & 7;
#pragma unroll
    for (int j = 0; j < 4; ++j) {
        const int nn = (lane >> 3) + 8 * j; const LAS float* sp = scr + (8 * c) * 33 + nn;
        u32x4 o; o.x = pk2(sp[0 * 33], sp[1 * 33]); o.y = pk2(sp[2 * 33], sp[3 * 33]); o.z = pk2(sp[4 * 33], sp[5 * 33]); o.w = pk2(sp[6 * 33], sp[7 * 33]);
        if (W3MODE) { if (n0 + nn < N) *(u32x4*)(WT + (size_t)w3_dst(n0 + nn) * K + k0 + 8 * c) = o; }
        else *(u32x4*)(WT + (size_t)(drow0 + nn) * K + k0 + 8 * c) = o;
    }
    asm volatile("s_waitcnt lgkmcnt(0)" ::: "memory");
}
__device__ __forceinline__ int perm16(int s) { const int i = s & 15; const int p = (i < 4 || i >= 12) ? i : (i < 8 ? i + 4 : i - 4); return (s & ~15) | p; }
__device__ __forceinline__ size_t vt_index(int bk, int SL, int d, int s) { return ((size_t)bk * SL * 64) + (size_t)(s >> 5) * 2048 + (size_t)d * 32 + (perm16(s) & 31); }

__device__ __forceinline__ unsigned q4(float a, float b, float c, float d, float inv) {
    const int i0 = (int)__builtin_rintf(a * inv), i1 = (int)__builtin_rintf(b * inv), i2 = (int)__builtin_rintf(c * inv), i3 = (int)__builtin_rintf(d * inv);
    return (unsigned)(i0 & 255) | ((unsigned)(i1 & 255) << 8) | ((unsigned)(i2 & 255) << 16) | ((unsigned)i3 << 24);
}
__device__ __forceinline__ float wave_max(float v) {
#pragma unroll
    for (int o = 1; o < 64; o <<= 1) v = fmaxf(v, __shfl_xor(v, o));
    return v;
}
__device__ __forceinline__ void quant_gu_item(const float* W, const float* gain, unsigned char* WQ, float* SB, int drow0, int n0, LAS unsigned char* lds, int tid, int lane, int wave) {
    constexpr int RSB = 1040;
    const int cq = tid & 7, kg = tid >> 3;
    f32x4 v[4][4];
#pragma unroll
    for (int i = 0; i < 4; ++i)
#pragma unroll
        for (int r = 0; r < 4; ++r) v[i][r] = *(const f32x4*)(W + (size_t)(4 * (64 * i + kg) + r) * DFF + n0 + 4 * cq);
    f32x4 mx = (f32x4){0.f, 0.f, 0.f, 0.f};
#pragma unroll
    for (int i = 0; i < 4; ++i) {
        const f32x4 gn = *(const f32x4*)(gain + 4 * (64 * i + kg));
#pragma unroll
        for (int r = 0; r < 4; ++r) { v[i][r] = v[i][r] * gn[r]; mx = __builtin_elementwise_max(mx, __builtin_elementwise_abs(v[i][r])); }
    }
#pragma unroll
    for (int e = 0; e < 4; ++e) { float t = mx[e]; t = fmaxf(t, __shfl_xor(t, 8)); t = fmaxf(t, __shfl_xor(t, 16)); t = fmaxf(t, __shfl_xor(t, 32)); mx[e] = t; }
    LAS float* red = (LAS float*)(lds + 32 * RSB);
    __syncthreads();
    if (lane < 8) *(LAS f32x4*)(red + wave * 32 + 4 * cq) = mx;
    __syncthreads();
#pragma unroll
    for (int w2 = 0; w2 < 8; ++w2) mx = __builtin_elementwise_max(mx, *(const LAS f32x4*)(red + w2 * 32 + 4 * cq));
    f32x4 inv;
#pragma unroll
    for (int e = 0; e < 4; ++e) inv[e] = mx[e] > 0.f ? 127.0f / mx[e] : 0.f;
    if (tid < 8) *(f32x4*)(SB + drow0 + 4 * cq) = mx * (1.0f / 127.0f);
#pragma unroll
    for (int i = 0; i < 4; ++i)
#pragma unroll
        for (int e = 0; e < 4; ++e)
            *(LAS unsigned*)(lds + (4 * cq + e) * RSB + 4 * (64 * i + kg)) = q4(v[i][0][e], v[i][1][e], v[i][2][e], v[i][3][e], inv[e]);
    __syncthreads();
#pragma unroll
    for (int j = 0; j < 4; ++j) {
        const int id = tid + 512 * j, row = id >> 6, c16 = id & 63;
        *(u32x4*)(WQ + (size_t)(drow0 + row) * DM + 16 * c16) = *(const LAS u32x4*)(lds + row * RSB + 16 * c16);
    }
}
__device__ __forceinline__ void quant_gu(const Args& a, int f, int it, LAS unsigned char* lds, int tid, int lane, int wave) {
    const int which = it / (DFF / 32), n0 = 32 * (it % (DFF / 32));
    quant_gu_item(a.in[f == 0 ? (which == 0 ? 7 : 8) : (which == 0 ? 18 : 19)], a.in[f == 0 ? 6 : 17], a.ws + (f == 0 ? WS_W1Q : WS_W5Q), (float*)(a.ws + (f == 0 ? WS_SB1 : WS_SB5)),
                  256 * (n0 >> 7) + (n0 & 127) + (which ? 128 : 0), n0, lds, tid, lane, wave);
}
__device__ __forceinline__ void quant_dn_item(const float* W, unsigned char* WF, float* SB, int n0, LAS unsigned char* lds, int tid, int lane, int wave) {
    constexpr int RSB = DFF + 16, NG = DFF / 4;
    const int cq = tid & 3, kg = tid >> 2;
    f32x4 v[6][4];
#pragma unroll
    for (int i = 0; i < 6; ++i)
#pragma unroll
        for (int r = 0; r < 4; ++r) { const int g = 128 * i + kg; v[i][r] = (i < 5 || g < NG) ? *(const f32x4*)(W + (size_t)(4 * g + r) * DM + n0 + 4 * cq) : (f32x4){0.f, 0.f, 0.f, 0.f}; }
    f32x4 mx = (f32x4){0.f, 0.f, 0.f, 0.f};
#pragma unroll
    for (int i = 0; i < 6; ++i)
#pragma unroll
        for (int r = 0; r < 4; ++r) mx = __builtin_elementwise_max(mx, __builtin_elementwise_abs(v[i][r]));
#pragma unroll
    for (int e = 0; e < 4; ++e) { float t = mx[e]; t = fmaxf(t, __shfl_xor(t, 4)); t = fmaxf(t, __shfl_xor(t, 8)); t = fmaxf(t, __shfl_xor(t, 16)); t = fmaxf(t, __shfl_xor(t, 32)); mx[e] = t; }
    LAS float* red = (LAS float*)(lds + 16 * RSB);
    __syncthreads();
    if (lane < 4) *(LAS f32x4*)(red + wave * 16 + 4 * cq) = mx;
    __syncthreads();
#pragma unroll
    for (int w2 = 0; w2 < 8; ++w2) mx = __builtin_elementwise_max(mx, *(const LAS f32x4*)(red + w2 * 16 + 4 * cq));
    f32x4 inv;
#pragma unroll
    for (int e = 0; e < 4; ++e) inv[e] = mx[e] > 0.f ? 256.0f / mx[e] : 0.f;
    if (tid < 4) *(f32x4*)(SB + n0 + 4 * cq) = mx * (1.0f / 256.0f);
#pragma unroll
    for (int i = 0; i < 6; ++i) {
        const int g = 128 * i + kg;
        if (i < 5 || g < NG) {
#pragma unroll
            for (int e = 0; e < 4; ++e)
                *(LAS unsigned*)(lds + (4 * cq + e) * RSB + 4 * g) = f8x4(v[i][0][e] * inv[e], v[i][1][e] * inv[e], v[i][2][e] * inv[e], v[i][3][e] * inv[e]);
        }
    }
    __syncthreads();
    for (int id = tid; id < 16 * (DFF / 16); id += 512) {
        const int row = id / (DFF / 16), c16 = id % (DFF / 16);
        *(u32x4*)(WF + (size_t)(n0 + row) * DFF + 16 * c16) = *(const LAS u32x4*)(lds + row * RSB + 16 * c16);
    }
}
constexpr int N_QDN = DM / 16;
constexpr int N_QGU = 2 * (DFF / 32);
__device__ __forceinline__ void convert_weights(const Args& a, int set, int w, int nw, LAS float* scr, int lane) {
    unsigned char* ws = a.ws;
    constexpr int I_DN = (DFF / 64) * (DM / 32), NB_IN = (DIN + 31) / 32, I_IN = (DM / 64) * NB_IN, I_OUT = (DM / 64) * (DM / 32);
    const int nitems = set == 0 ? I_DN + I_IN + I_OUT : I_DN;
    for (int it = w; it < nitems; it += nw) {
        int r = it;
        if (r < I_DN) {
            const int nblk = DM / 32, kb = r / nblk, nb = r % nblk;
            p0_transpose_item(a.in[set == 0 ? 9 : 20], DFF, DM, nullptr, (bf16_t*)(ws + (set == 0 ? WS_W2T : WS_W6T)), 32 * nb, 64 * kb, 32 * nb, scr, lane); continue; }
        r -= I_DN;
        if (r < I_IN) { const int kb = r / NB_IN, nb = r % NB_IN;
            p0_transpose_item<true>(a.in[11], DM, DIN, a.in[10], (bf16_t*)(ws + WS_W3T), 0, 64 * kb, 32 * nb, scr, lane); continue; }
        r -= I_IN;
        { const int nblk = DM / 32, kb = r / nblk, nb = r % nblk;
            p0_transpose_item(a.in[16], DM, DM, nullptr, (bf16_t*)(ws + WS_W4T), 32 * nb, 64 * kb, 32 * nb, scr, lane); }
    }
}

__device__ __forceinline__ void p0_prologue(const Args& a, LAS unsigned char* lds, int vcu, int G, int tid, int wave, int lane) {
    unsigned char* ws = a.ws;
    LAS float* scr = (LAS float*)(lds + wave * 16384);
    const int gw = vcu * NWAVES + wave, NGW = G * NWAVES;
    if (vcu < N_QGU) { quant_gu(a, 0, vcu, lds, tid, lane, wave); __syncthreads(); }
    convert_weights(a, 0, gw, NGW, scr, lane);
    for (int r = 11 * 256 + gw; r < NZ; r += NGW)
        if (w3_src(r) < 0) { u32x4* p = (u32x4*)((bf16_t*)(ws + WS_W3T) + (size_t)r * DM) + lane; p[0] = (u32x4){0u, 0u, 0u, 0u}; p[64] = (u32x4){0u, 0u, 0u, 0u}; }
    bf16_t* AB = (bf16_t*)(ws + WS_AB); float* RM = (float*)(ws + WS_RM1); unsigned* XQ = (unsigned*)(ws + WS_XQ);
    for (int m = gw; m < MT; m += NGW) {
        const float* xrow = (m < MP) ? a.in[0] + (size_t)m * DM : a.in[1] + (size_t)(m - MP) * DM;
        const f32x4* xr = (const f32x4*)xrow + lane;
        f32x4 v[4]; float s = 0.f;
#pragma unroll
        for (int j = 0; j < 4; ++j) { v[j] = xr[64 * j]; s += (v[j][0] * v[j][0] + v[j][1] * v[j][1]) + (v[j][2] * v[j][2] + v[j][3] * v[j][3]); }
        float am = 0.f;
#pragma unroll
        for (int j = 0; j < 4; ++j) am = fmaxf(fmaxf(am, fmaxf(fabsf(v[j][0]), fabsf(v[j][1]))), fmaxf(fabsf(v[j][2]), fabsf(v[j][3])));
        s = wave_sum(s); am = wave_max(am);
        const float inv = am > 0.f ? 127.0f / am : 0.f;
#pragma unroll
        for (int j = 0; j < 4; ++j) XQ[(size_t)m * (DM / 4) + 64 * j + lane] = q4(v[j][0], v[j][1], v[j][2], v[j][3], inv);
        if (lane == 0) RM[m] = __builtin_amdgcn_rsqf(s * (1.0f / DM) + EPS) * (am * (1.0f / 127.0f));
        u32x2* o8 = (u32x2*)(AB + (size_t)m * DM) + lane;
#pragma unroll
        for (int j = 0; j < 4; ++j) { u32x2 w; w.x = pk2(v[j][0], v[j][1]); w.y = pk2(v[j][2], v[j][3]); o8[64 * j] = w; }
    }
    const int gt = vcu * (NWAVES * 64) + tid, NGT = G * NWAVES * 64;
    bf16_t* KS = (bf16_t*)(ws + WS_KS); bf16_t* VTS = (bf16_t*)(ws + WS_VTS); bf16_t* KIS = (bf16_t*)(ws + WS_KIS);
    for (int e4 = gt; e4 < 8 * PAST * 128 / 4; e4 += NGT) {
        const int f = 4 * e4, d = f & 63, kv = (f >> 6) & 1, s = (f >> 7) & (PAST - 1), b = f >> 17;
        const f32x4 k = *(const f32x4*)(a.in[2] + f), v = *(const f32x4*)(a.in[3] + f);
        u32x2 w; w.x = pk2(k[0], k[1]); w.y = pk2(k[2], k[3]);
        *(u32x2*)(KS + ((size_t)(b * 2 + kv) * LSP + s) * 64 + d) = w;
        bf16_t* vt = VTS + vt_index(b * 2 + kv, LSP, d, s);
        vt[0] = (bf16_t)f2bf(v[0]); vt[32] = (bf16_t)f2bf(v[1]); vt[64] = (bf16_t)f2bf(v[2]); vt[96] = (bf16_t)f2bf(v[3]);
    }
    for (int e4 = gt; e4 < 8 * PAST * 64 / 4; e4 += NGT) {
        const int f = 4 * e4, d = f & 63, s = (f >> 6) & (PAST - 1), b = f >> 16;
        const f32x4 k = *(const f32x4*)(a.in[4] + f) * 0.125f;
        u32x2 w; w.x = pk2(k[0], k[1]); w.y = pk2(k[2], k[3]);
        *(u32x2*)(KIS + ((size_t)b * LSP + s) * 64 + d) = w;
    }
    for (int e = gt; e < 8 * 2 * 16 * 64; e += NGT) {
        const int d = e & 63, s = LSK + ((e >> 6) & 15), bk = e >> 10;
        KS[((size_t)bk * LSP + s) * 64 + d] = 0; VTS[vt_index(bk, LSP, d, s)] = 0;
    }
    for (int e = gt; e < 8 * 16 * 64; e += NGT) { const int d = e & 63, s = LSK + ((e >> 6) & 15), b = e >> 10; KIS[((size_t)b * LSP + s) * 64 + d] = 0; }
    float* TAB = (float*)(ws + WS_TAB);
    for (int e = gt; e < TP * 8; e += NGT) {
        const int pos = e >> 3, i = e & 7;
        const float invf[8] = {1.0f, 0.1939227432012558f, 0.03760603070259094f, 0.007292664609849453f, 0.0014142135623842478f, 0.00027424818836152554f, 5.318296098266728e-05f, 1.0313386155758053e-05f};
        float inv = invf[0];
#pragma unroll
        for (int j = 1; j < 8; ++j) inv = (i == j) ? invf[j] : inv;
        const float angf = (float)pos * inv;
        double x = (double)angf;
        const double TWO_PI = 6.283185307179586476925287, INV_2PI = 0.15915494309189533576888;
        double kq = __builtin_rint(x * INV_2PI); x = x - kq * TWO_PI;
        const double x2 = x * x;
        double sn = 1.0 / 51090942171709440000.0, cs = 1.0 / 2432902008176640000.0;
        const double rf[10] = {1.0 / 121645100408832000.0, 1.0 / 6402373705728000.0, 1.0 / 355687428096000.0, 1.0 / 20922789888000.0, 1.0 / 1307674368000.0, 1.0 / 87178291200.0, 1.0 / 6227020800.0, 1.0 / 479001600.0, 1.0 / 39916800.0, 1.0 / 3628800.0};
        sn = -sn * x2 + rf[0]; cs = -cs * x2 + rf[1];
        sn = -sn * x2 + rf[2]; cs = -cs * x2 + rf[3];
        sn = -sn * x2 + rf[4]; cs = -cs * x2 + rf[5];
        sn = -sn * x2 + rf[6]; cs = -cs * x2 + rf[7];
        sn = -sn * x2 + rf[8]; cs = -cs * x2 + rf[9];
        sn = -sn * x2 + 1.0 / 362880.0; cs = -cs * x2 + 1.0 / 40320.0;
        sn = -sn * x2 + 1.0 / 5040.0; cs = -cs * x2 + 1.0 / 720.0;
        sn = -sn * x2 + 1.0 / 120.0; cs = -cs * x2 + 1.0 / 24.0;
        sn = -sn * x2 + 1.0 / 6.0; cs = -cs * x2 + 0.5;
        sn = -sn * x2 + 1.0; cs = -cs * x2 + 1.0;
        sn = sn * x;
        TAB[pos * 16 + i] = (float)cs; TAB[pos * 16 + 8 + i] = (float)sn;
    }
}

template <int NR>
__device__ __forceinline__ void quant_rows(const bf16_t* X, unsigned char* XQ, float* RM, int m0, int nrows, int lane) {
    u32x4 w[NR][2];
#pragma unroll
    for (int r = 0; r < NR; ++r) { const int m = m0 + (r < nrows ? r : 0); const u32x4* xr = (const u32x4*)(X + (size_t)m * DM) + lane; w[r][0] = xr[0]; w[r][1] = xr[64]; }
#pragma unroll
    for (int r = 0; r < NR; ++r) {
        float x[16];
#pragma unroll
        for (int h = 0; h < 2; ++h)
#pragma unroll
            for (int j = 0; j < 4; ++j) { x[8 * h + 2 * j] = __builtin_bit_cast(float, w[r][h][j] << 16); x[8 * h + 2 * j + 1] = __builtin_bit_cast(float, w[r][h][j] & 0xffff0000u); }
        float s = 0.f, am = 0.f;
#pragma unroll
        for (int j = 0; j < 16; ++j) { s += x[j] * x[j]; am = fmaxf(am, fabsf(x[j])); }
        s = wave_sum(s); am = wave_max(am);
        const float inv = am > 0.f ? 127.0f / am : 0.f;
        if (r < nrows) {
            const int m = m0 + r;
#pragma unroll
            for (int h = 0; h < 2; ++h) { u32x2 o; o.x = q4(x[8 * h], x[8 * h + 1], x[8 * h + 2], x[8 * h + 3], inv); o.y = q4(x[8 * h + 4], x[8 * h + 5], x[8 * h + 6], x[8 * h + 7], inv);
                *((u32x2*)(XQ + (size_t)m * DM) + 64 * h + lane) = o; }
            if (lane == 0) RM[m] = __builtin_amdgcn_rsqf(s * (1.0f / DM) + EPS) * (am * (1.0f / 127.0f));
        }
    }
}

__device__ __forceinline__ void norm_rope8(float (&x)[8], bool do_norm, const float* gain, bool do_rope, const f32x4 (&cs)[2], const f32x4 (&sn)[2], int lane) {
    float ss = 0.f;
#pragma unroll
    for (int j = 0; j < 8; ++j) ss += x[j] * x[j];
    ss += __shfl_xor(ss, 1); ss += __shfl_xor(ss, 2); ss += __shfl_xor(ss, 4);
    const float rs = do_norm ? __builtin_amdgcn_rsqf(ss * (1.0f / 64.0f) + EPS) : 1.0f;
#pragma unroll
    for (int j = 0; j < 8; ++j) x[j] = x[j] * rs * (gain ? gain[j] : 1.0f);
    const int sub = lane & 7;
    float p[8];
#pragma unroll
    for (int j = 0; j < 8; ++j) p[j] = __shfl_xor(x[j], 1);
    if (do_rope && sub < 2) {
#pragma unroll
        for (int j = 0; j < 8; ++j) {
            const float c = cs[j >> 2][j & 3], s = sn[j >> 2][j & 3];
            x[j] = (sub == 0) ? (x[j] * c - p[j] * s) : (p[j] * s + x[j] * c);
        }
    }
}
__device__ __forceinline__ void ld8bf(const bf16_t* p, float (&x)[8]) {
    const u32x4 w = *(const u32x4*)p;
    x[0] = __builtin_bit_cast(float, w.x << 16); x[1] = __builtin_bit_cast(float, w.x & 0xffff0000u);
    x[2] = __builtin_bit_cast(float, w.y << 16); x[3] = __builtin_bit_cast(float, w.y & 0xffff0000u);
    x[4] = __builtin_bit_cast(float, w.z << 16); x[5] = __builtin_bit_cast(float, w.z & 0xffff0000u);
    x[6] = __builtin_bit_cast(float, w.w << 16); x[7] = __builtin_bit_cast(float, w.w & 0xffff0000u);
}
__device__ __forceinline__ u32x4 pk8(const float (&x)[8]) { u32x4 w; w.x = pk2(x[0], x[1]); w.y = pk2(x[2], x[3]); w.z = pk2(x[4], x[5]); w.w = pk2(x[6], x[7]); return w; }

__device__ __forceinline__ void pz_row(const Args& a, int m, int lane) {
    unsigned char* ws = a.ws;
    const bf16_t* Z = (const bf16_t*)(ws + WS_R1); const float* ZL = (const float*)(ws + WS_ZL); const float* TAB = (const float*)(ws + WS_TAB);
    bf16_t* A4 = (bf16_t*)(ws + WS_A4); bf16_t* QB = (bf16_t*)(ws + WS_QB); bf16_t* QIB = (bf16_t*)(ws + WS_QIB); float* WIF = (float*)(ws + WS_WIF);
    const float* convw = a.in[12]; const float* qn = a.in[13]; const float* kn = a.in[14]; const float* ikn = a.in[15]; const float* stc = a.in[5];
    float* out = a.out;
    {
        const bool samp = m >= MP; const int ms = m - MP;
        const int b = samp ? (ms >> 4) : (m >> 11), t = samp ? (ms & 15) : (m & 2047), pos = samp ? PAST + t : t, T = samp ? TSQ : TP;
        const bf16_t* zr = Z + (size_t)m * ZS;
        f32x4 cs[2], sn[2];
        cs[0] = *(const f32x4*)(TAB + pos * 16); cs[1] = *(const f32x4*)(TAB + pos * 16 + 4); sn[0] = *(const f32x4*)(TAB + pos * 16 + 8); sn[1] = *(const f32x4*)(TAB + pos * 16 + 12);
        {
            const int c0 = 8 * lane;
            float gb[8], gc[8], xv[8], u0[8], u1[8], u2[8];
            ld8bf(zr + C_GB + c0, gb); ld8bf(zr + C_GC + c0, gc); ld8bf(zr + C_XV + c0, xv);
#pragma unroll
            for (int j = 0; j < 8; ++j) u2[j] = gc[j] * xv[j];
            if (t >= 1) { float g1[8], x1[8]; ld8bf(zr - ZS + C_GC + c0, g1); ld8bf(zr - ZS + C_XV + c0, x1);
#pragma unroll
                for (int j = 0; j < 8; ++j) u1[j] = g1[j] * x1[j]; }
            else {
#pragma unroll
                for (int j = 0; j < 8; ++j) u1[j] = samp ? stc[(size_t)(b * 2 + 1) * 512 + c0 + j] : 0.f; }
            if (t >= 2) { float g1[8], x1[8]; ld8bf(zr - 2 * ZS + C_GC + c0, g1); ld8bf(zr - 2 * ZS + C_XV + c0, x1);
#pragma unroll
                for (int j = 0; j < 8; ++j) u0[j] = g1[j] * x1[j]; }
            else {
#pragma unroll
                for (int j = 0; j < 8; ++j) u0[j] = samp ? stc[(size_t)(b * 2 + t) * 512 + c0 + j] : 0.f; }
            float co[8];
#pragma unroll
            for (int j = 0; j < 8; ++j) co[j] = gb[j] * (u0[j] * convw[c0 + j] + u1[j] * convw[512 + c0 + j] + u2[j] * convw[1024 + c0 + j]);
            *(u32x4*)(A4 + (size_t)m * DM + c0) = pk8(co);
            if (t >= T - 2) {
                float* cp = out + (samp ? O_CS : O_CP) + (size_t)(b * 2 + (t - (T - 2))) * 512 + c0;
                *(f32x4*)cp = (f32x4){u2[0], u2[1], u2[2], u2[3]}; *(f32x4*)(cp + 4) = (f32x4){u2[4], u2[5], u2[6], u2[7]};
            }
        }
        {
            float x[8]; ld8bf(zr + C_Q + 8 * lane, x);
            float g[8];
#pragma unroll
            for (int j = 0; j < 8; ++j) g[j] = qn[8 * (lane & 7) + j];
            norm_rope8(x, true, g, true, cs, sn, lane);
#pragma unroll
            for (int j = 0; j < 8; ++j) x[j] *= QSCALE;
            *(u32x4*)(QB + (size_t)m * 512 + 8 * lane) = pk8(x);
        }
        {
            float x[8]; ld8bf(zr + C_QI + 8 * lane, x);
            norm_rope8(x, false, nullptr, true, cs, sn, lane);
            *(u32x4*)(QIB + (size_t)m * 512 + 8 * lane) = pk8(x);
        }
        {
            float x[8];
            const int role = lane >> 3;
            if (lane < 32) ld8bf(zr + C_K + 8 * lane, x);
            else if (lane < 48) { const float* zl = ZL + (size_t)m * 128 + 8 * (lane - 32); const f32x4 v0 = *(const f32x4*)zl, v1 = *(const f32x4*)(zl + 4);
                x[0] = v0[0]; x[1] = v0[1]; x[2] = v0[2]; x[3] = v0[3]; x[4] = v1[0]; x[5] = v1[1]; x[6] = v1[2]; x[7] = v1[3]; }
            else {
#pragma unroll
                for (int j = 0; j < 8; ++j) x[j] = 0.f; }
            float g[8];
#pragma unroll
            for (int j = 0; j < 8; ++j) g[j] = (role < 2) ? kn[8 * (lane & 7) + j] : (role == 4 ? ikn[8 * (lane & 7) + j] : 1.0f);
            const bool nr = (role < 2) || (role == 4);
            norm_rope8(x, nr, g, nr, cs, sn, lane);
            const int s_key = samp ? PAST + t : t;
            if (role < 2) {
                float* kp = out + (samp ? O_KS : O_KP) + ((size_t)(samp ? ms : m)) * 128 + 8 * lane;
                *(f32x4*)kp = (f32x4){x[0], x[1], x[2], x[3]}; *(f32x4*)(kp + 4) = (f32x4){x[4], x[5], x[6], x[7]};
                bf16_t* kb = samp ? (bf16_t*)(ws + WS_KS) + ((size_t)(b * 2 + role) * LSP + s_key) * 64 : (bf16_t*)(ws + WS_KP) + ((size_t)(b * 2 + role) * TP + s_key) * 64;
                *(u32x4*)(kb + 8 * (lane & 7)) = pk8(x);
            } else if (role < 4) {
                float* vp = out + (samp ? O_VS : O_VP) + ((size_t)(samp ? ms : m)) * 128 + 8 * (lane - 16);
                *(f32x4*)vp = (f32x4){x[0], x[1], x[2], x[3]}; *(f32x4*)(vp + 4) = (f32x4){x[4], x[5], x[6], x[7]};
                const int kv = role - 2, SL = samp ? LSP : TP;
                bf16_t* vt = (samp ? (bf16_t*)(ws + WS_VTS) : (bf16_t*)(ws + WS_VTP)) + vt_index(b * 2 + kv, SL, 8 * (lane & 7), s_key);
#pragma unroll
                for (int j = 0; j < 8; ++j) vt[j * 32] = (bf16_t)f2bf(x[j]);
            } else if (role == 4) {
                float* ip = out + (samp ? O_IS : O_IP) + ((size_t)(samp ? ms : m)) * 64 + 8 * (lane & 7);
                *(f32x4*)ip = (f32x4){x[0], x[1], x[2], x[3]}; *(f32x4*)(ip + 4) = (f32x4){x[4], x[5], x[6], x[7]};
#pragma unroll
                for (int j = 0; j < 8; ++j) x[j] *= 0.125f;
                bf16_t* kib = samp ? (bf16_t*)(ws + WS_KIS) + ((size_t)b * LSP + s_key) * 64 : (bf16_t*)(ws + WS_KIP) + ((size_t)b * TP + s_key) * 64;
                *(u32x4*)(kib + 8 * (lane & 7)) = pk8(x);
            } else if (lane == 40) {
                float* wp = WIF + (size_t)m * 8;
                *(f32x4*)wp = (f32x4){x[0] * WISCALE, x[1] * WISCALE, x[2] * WISCALE, x[3] * WISCALE}; *(f32x4*)(wp + 4) = (f32x4){x[4] * WISCALE, x[5] * WISCALE, x[6] * WISCALE, x[7] * WISCALE};
            }
        }
    }
}

__device__ __forceinline__ void conv_rows4(const Args& a, int mfirst, int lane) {
    unsigned char* ws = a.ws;
    const bf16_t* GBUF = (const bf16_t*)(ws + WS_GB); const bf16_t* UBUF = (const bf16_t*)(ws + WS_UB); bf16_t* A4 = (bf16_t*)(ws + WS_A4);
    const float* convw = a.in[12];
    const int c0 = 8 * lane;
    u32x4 g[4], x0[4], x1[4], x2[4];
#pragma unroll
    for (int i = 0; i < 4; ++i) {
        const int m = mfirst + 8 * i, t = m & (TP - 1);
        g[i] = *(const u32x4*)(GBUF + (size_t)m * 512 + c0); x2[i] = *(const u32x4*)(UBUF + (size_t)m * 512 + c0);
        x1[i] = (u32x4){0u, 0u, 0u, 0u}; x0[i] = (u32x4){0u, 0u, 0u, 0u};
        if (t >= 1) x1[i] = *(const u32x4*)(UBUF + (size_t)(m - 1) * 512 + c0);
        if (t >= 2) x0[i] = *(const u32x4*)(UBUF + (size_t)(m - 2) * 512 + c0);
    }
    const f32x4 wa0 = *(const f32x4*)(convw + c0), wa1 = *(const f32x4*)(convw + c0 + 4), wb0 = *(const f32x4*)(convw + 512 + c0), wb1 = *(const f32x4*)(convw + 512 + c0 + 4),
                wc0 = *(const f32x4*)(convw + 1024 + c0), wc1 = *(const f32x4*)(convw + 1024 + c0 + 4);
#pragma unroll
    for (int i = 0; i < 4; ++i) {
        const unsigned gw[4] = {g[i].x, g[i].y, g[i].z, g[i].w}, a0[4] = {x0[i].x, x0[i].y, x0[i].z, x0[i].w}, a1[4] = {x1[i].x, x1[i].y, x1[i].z, x1[i].w}, a2[4] = {x2[i].x, x2[i].y, x2[i].z, x2[i].w};
        float co[8];
#pragma unroll
        for (int j = 0; j < 8; ++j) {
            const int d = j >> 1; const bool hi = j & 1;
            const float gb = __builtin_bit_cast(float, hi ? (gw[d] & 0xffff0000u) : (gw[d] << 16));
            const float u0 = __builtin_bit_cast(float, hi ? (a0[d] & 0xffff0000u) : (a0[d] << 16));
            const float u1 = __builtin_bit_cast(float, hi ? (a1[d] & 0xffff0000u) : (a1[d] << 16));
            const float u2 = __builtin_bit_cast(float, hi ? (a2[d] & 0xffff0000u) : (a2[d] << 16));
            const float w0 = j < 4 ? wa0[j & 3] : wa1[j & 3], w1 = j < 4 ? wb0[j & 3] : wb1[j & 3], w2 = j < 4 ? wc0[j & 3] : wc1[j & 3];
            co[j] = gb * (u0 * w0 + u1 * w1 + u2 * w2);
        }
        *(u32x4*)(A4 + (size_t)(mfirst + 8 * i) * DM + c0) = pk8(co);
    }
}

#define MFMA32(a, b, c) __builtin_amdgcn_mfma_f32_32x32x16_bf16(a, b, c, 0, 0, 0)
constexpr int SC_ROW = 2056;
constexpr int BM_OFF = 32 * SC_ROW * 2, BM_ROW = 260;
constexpr int N_UNITS = 520;
#define MFMA16(a, b, c) __builtin_amdgcn_mfma_f32_16x16x32_bf16(a, b, c, 0, 0, 0)

#ifndef ATTN_REP_A
#define ATTN_REP_A 1
#endif
#ifndef ATTN_REP_SEL
#define ATTN_REP_SEL 1
#endif
#ifndef ATTN_REP_B
#define ATTN_REP_B 1
#endif
__device__ __forceinline__ int wave_incl_scan(int v) {
    v += __builtin_amdgcn_update_dpp(0, v, 0x111, 0xf, 0xf, false);
    v += __builtin_amdgcn_update_dpp(0, v, 0x112, 0xf, 0xf, false);
    v += __builtin_amdgcn_update_dpp(0, v, 0x114, 0xf, 0xf, false);
    v += __builtin_amdgcn_update_dpp(0, v, 0x118, 0xf, 0xf, false);
    v += __builtin_amdgcn_update_dpp(0, v, 0x142, 0xa, 0xf, false);
    v += __builtin_amdgcn_update_dpp(0, v, 0x143, 0xc, 0xf, false);
    return v;
}
__device__ __forceinline__ int hist_pivot(LAS unsigned* H, int target, int lane, int& above, int& here) {
    const u32x4 h4 = ((LAS u32x4*)H)[lane];
    const int s = (int)(h4.x + h4.y + h4.z + h4.w);
    const int P = wave_incl_scan(s);
    const int total = __builtin_amdgcn_readlane(P, 63);
    const int suffix = total - P + s;
    const unsigned long long m = __ballot(suffix >= target);
    const int lp = 63 - __builtin_clzll(m | 1ull);
    int ab = __builtin_amdgcn_readlane(suffix, lp) - __builtin_amdgcn_readlane(s, lp);
    const int hw = __builtin_amdgcn_readlane((int)h4.w, lp), hz = __builtin_amdgcn_readlane((int)h4.z, lp), hy = __builtin_amdgcn_readlane((int)h4.y, lp), hx = __builtin_amdgcn_readlane((int)h4.x, lp);
    int b, hr;
    if (ab + hw >= target) { b = 3; hr = hw; }
    else { ab += hw; if (ab + hz >= target) { b = 2; hr = hz; } else { ab += hz; if (ab + hy >= target) { b = 1; hr = hy; } else { ab += hy; b = 0; hr = hx; } } }
    above = ab; here = hr;
    return 4 * lp + b;
}
template <int NCH>
__device__ __forceinline__ void select_row(LAS unsigned short* SC, LAS unsigned char* BM, LAS unsigned* H, int qq, int nch, int lane) {
    unsigned key[8 * NCH];
    LAS u32x4* rowp = (LAS u32x4*)(SC + qq * SC_ROW);
    {
        u32x4 v[NCH];
#pragma unroll
        for (int i = 0; i < NCH; ++i) { v[i] = (u32x4){0u, 0u, 0u, 0u}; if (lane + 64 * i < nch) v[i] = rowp[lane + 64 * i]; }
#pragma unroll
        for (int i = 0; i < NCH; ++i) {
            const bool act = lane + 64 * i < nch;
            const unsigned w[4] = {v[i].x, v[i].y, v[i].z, v[i].w};
#pragma unroll
            for (int d = 0; d < 4; ++d) {
                const unsigned lo = w[d] & 0xffffu, hi = w[d] >> 16;
                key[8 * i + 2 * d] = act ? ((lo & 0x8000u) ? (~lo & 0xffffu) : (lo | 0x8000u)) : 0u;
                key[8 * i + 2 * d + 1] = act ? ((hi & 0x8000u) ? (~hi & 0xffffu) : (hi | 0x8000u)) : 0u;
            }
        }
    }
    unsigned T = 0u; int cgt = 0, nties = 0;
#pragma unroll 1
    for (int rep_ = 0; rep_ < ATTN_REP_SEL; ++rep_) {
        asm volatile("" : "+v"(key[0]));
        ((LAS u32x4*)H)[lane] = (u32x4){0u, 0u, 0u, 0u};
        asm volatile("" ::: "memory");
#pragma unroll
        for (int i = 0; i < NCH; ++i)
            if (lane + 64 * i < nch) {
#pragma unroll
                for (int e2 = 0; e2 < 8; ++e2) __hip_atomic_fetch_add(H + (key[8 * i + e2] >> 8), 1u, __ATOMIC_RELAXED, __HIP_MEMORY_SCOPE_WORKGROUP);
            }
        asm volatile("s_waitcnt lgkmcnt(0)" ::: "memory");
        int above1, here1;
        const unsigned p1 = (unsigned)hist_pivot(H, 256, lane, above1, here1);
        asm volatile("" ::: "memory");
        ((LAS u32x4*)H)[lane] = (u32x4){0u, 0u, 0u, 0u};
        asm volatile("" ::: "memory");
#pragma unroll
        for (int i = 0; i < NCH; ++i)
#pragma unroll
            for (int e2 = 0; e2 < 8; ++e2)
                if ((key[8 * i + e2] >> 8) == p1 && lane + 64 * i < nch) __hip_atomic_fetch_add(H + (key[8 * i + e2] & 255u), 1u, __ATOMIC_RELAXED, __HIP_MEMORY_SCOPE_WORKGROUP);
        asm volatile("s_waitcnt lgkmcnt(0)" ::: "memory");
        int above2, here2;
        const unsigned p2 = (unsigned)hist_pivot(H, 256 - above1, lane, above2, here2);
        asm volatile("" ::: "memory");
        T = (p1 << 8) | p2; cgt = above1 + above2; nties = here2;
    }
    int budget[NCH];
#pragma unroll
    for (int i = 0; i < NCH; ++i) budget[i] = 1 << 20;
    if (cgt + nties != 256) {
        int need = 256 - cgt;
#pragma unroll
        for (int i = 0; i < NCH; ++i) {
            int mine = 0;
#pragma unroll
            for (int e2 = 0; e2 < 8; ++e2) mine += (key[8 * i + e2] == T) ? 1 : 0;
            const int pre = wave_incl_scan(mine);
            budget[i] = need - (pre - mine);
            need -= __builtin_amdgcn_readlane(pre, 63);
        }
    }
#pragma unroll
    for (int i = 0; i < NCH; ++i) {
        unsigned nb = 0u; int tc = 0;
#pragma unroll
        for (int e2 = 0; e2 < 8; ++e2) {
            const bool tie = key[8 * i + e2] == T;
            const bool sel = (key[8 * i + e2] > T) || (tie && tc < budget[i]);
            tc += tie ? 1 : 0;
            nb |= sel ? 0u : (1u << e2);
        }
        if (lane + 64 * i < nch) BM[qq * BM_ROW + lane + 64 * i] = (unsigned char)nb;
    }
}

__device__ __forceinline__ void attn_unit(const Args& a, LAS unsigned char* lds, int e, int tid, int wave, int lane) {
    unsigned char* ws = a.ws;
    const int q = lane & 31, hh = lane >> 5;
    bool samp; int b, j;
    if (e < 256) { samp = false; j = 63 - (e >> 3); b = e & 7; }
    else if (e < 264) { samp = true; j = 0; b = e - 256; }
    else { samp = false; const int e2 = e - 8; j = 63 - (e2 >> 3); b = e2 & 7; }
    const int m0 = samp ? MP + 16 * b : b * TP + 32 * j;
    const int nq = samp ? 16 : 32;
    const int L = samp ? LSK : 64 * ((j >> 1) + 1);
    const int ntiles = (L + 31) >> 5;
    const int SL = samp ? LSP : TP;
    const bf16_t* Kb = samp ? (const bf16_t*)(ws + WS_KS) + (size_t)b * 2 * LSP * 64 : (const bf16_t*)(ws + WS_KP) + (size_t)b * 2 * TP * 64;
    const bf16_t* Vt = samp ? (const bf16_t*)(ws + WS_VTS) + (size_t)b * 2 * 64 * LSP : (const bf16_t*)(ws + WS_VTP) + (size_t)b * 2 * 64 * TP;
    const bf16_t* KI = samp ? (const bf16_t*)(ws + WS_KIS) + (size_t)b * LSP * 64 : (const bf16_t*)(ws + WS_KIP) + (size_t)b * TP * 64;
    LAS unsigned short* SC = (LAS unsigned short*)lds;
    LAS unsigned char* BM = lds + BM_OFF;

#if !CONV_TAIL
    if (!samp) conv_rows4(a, m0 + wave, lane);
#endif
    bf16x8 qb[2][4];
#define LOAD_QB() do { const int qrow_ = m0 + (q < nq ? q : nq - 1); const bf16_t* qp_ = (const bf16_t*)(ws + WS_QB) + (size_t)qrow_ * 512 + 128 * (wave & 3) + 8 * hh; \
        _Pragma("unroll") for (int hd = 0; hd < 2; ++hd) _Pragma("unroll") for (int ks = 0; ks < 4; ++ks) qb[hd][ks] = *(const bf16x8*)(qp_ + 64 * hd + 16 * ks); } while (0)
    if (L > 256) {
#ifndef NO_PASSA
        {
            const int q16 = lane & 15, g4 = lane >> 4, nt16 = L >> 4;
#pragma unroll 1
            for (int sw_ = 0; sw_ < ATTN_REP_A; ++sw_) {
                const int sw = wave >> 2, w4 = wave & 3; asm volatile("" ::: "memory");
                const int qi_ = 16 * sw + q16;
                bf16x8 kfa[4][2], kfb[4][2];
#define PA_LOAD(dst, base) do { _Pragma("unroll") for (int u = 0; u < 4; ++u) { int tt = (base) + 4 * u; tt = tt < nt16 ? tt : nt16 - 1; \
                        const bf16_t* kp_ = KI + (size_t)(16 * tt + q16) * 64 + 8 * g4; dst[u][0] = *(const bf16x8*)kp_; dst[u][1] = *(const bf16x8*)(kp_ + 32); } } while (0)
                PA_LOAD(kfa, w4);
                const int qrow = m0 + (qi_ < nq ? qi_ : nq - 1);
                const bf16_t* qip = (const bf16_t*)(ws + WS_QIB) + (size_t)qrow * 512 + 8 * g4;
                bf16x8 qf[8][2];
#pragma unroll
                for (int h = 0; h < 8; ++h)
#pragma unroll
                    for (int ks = 0; ks < 2; ++ks) qf[h][ks] = *(const bf16x8*)(qip + 64 * h + 32 * ks);
                const float* wip = (const float*)(ws + WS_WIF) + (size_t)qrow * 8;
                const f32x4 w0 = *(const f32x4*)wip, w1 = *(const f32x4*)(wip + 4);
                const float wi[8] = {0.5f * w0[0], 0.5f * w0[1], 0.5f * w0[2], 0.5f * w0[3], 0.5f * w1[0], 0.5f * w1[1], 0.5f * w1[2], 0.5f * w1[3]};
                bf16x8 ql[2];
#pragma unroll
                for (int ks = 0; ks < 2; ++ks) {
                    float t8[8];
#pragma unroll
                    for (int j2 = 0; j2 < 8; ++j2) t8[j2] = 0.f;
#pragma unroll
                    for (int h = 0; h < 8; ++h)
#pragma unroll
                        for (int j2 = 0; j2 < 8; ++j2) t8[j2] = __builtin_fmaf(wi[h], bf2f((unsigned short)qf[h][ks][j2]), t8[j2]);
                    u32x4 w; w.x = pk2(t8[0], t8[1]); w.y = pk2(t8[2], t8[3]); w.z = pk2(t8[4], t8[5]); w.w = pk2(t8[6], t8[7]);
                    ql[ks] = __builtin_bit_cast(bf16x8, w);
                }
#define PA_COMP(src, base) do { _Pragma("unroll") for (int u = 0; u < 4; ++u) { const int tt = (base) + 4 * u; if (tt < nt16) { \
                        f32x4 sc = (f32x4){0.f, 0.f, 0.f, 0.f}; \
                        sc = MFMA16(src[u][0], ql[0], sc); sc = MFMA16(src[u][1], ql[1], sc); \
                        _Pragma("unroll") for (int h = 0; h < 8; ++h) { f32x4 c = (f32x4){0.f, 0.f, 0.f, 0.f}; \
                            c = MFMA16(src[u][0], qf[h][0], c); c = MFMA16(src[u][1], qf[h][1], c); \
                            _Pragma("unroll") for (int r = 0; r < 4; ++r) sc[r] = __builtin_fmaf(__builtin_fabsf(c[r]), wi[h], sc[r]); } \
                        const _Float16 h0 = (_Float16)sc[0], h1 = (_Float16)sc[1], h2 = (_Float16)sc[2], h3 = (_Float16)sc[3]; \
                        u32x2 w; \
                        w.x = (unsigned)__builtin_bit_cast(unsigned short, h0) | ((unsigned)__builtin_bit_cast(unsigned short, h1) << 16); \
                        w.y = (unsigned)__builtin_bit_cast(unsigned short, h2) | ((unsigned)__builtin_bit_cast(unsigned short, h3) << 16); \
                        *(LAS u32x2*)(SC + qi_ * SC_ROW + 16 * tt + 4 * g4) = w; } } } while (0)
                for (int base = w4; base < nt16; base += 32) {
                    PA_LOAD(kfb, base + 16);
                    PA_COMP(kfa, base);
                    if (base + 16 < nt16) { PA_LOAD(kfa, base + 32); PA_COMP(kfb, base + 16); }
                }
#undef PA_LOAD
#undef PA_COMP
            }
            if (samp && tid < 32 * 8) {
                const int r = tid >> 3, d = tid & 7;
                ((LAS unsigned*)(SC + r * SC_ROW + LSK))[d] = 0xFC00FC00u;
            }
        }
#endif
        __syncthreads();
        LOAD_QB();
#ifndef NO_SEL
        {
            const int nch = ntiles * 4;
            const int ncl = (nch + 63) >> 6;
            for (int qq = wave; qq < nq; qq += 8) {
                LAS unsigned* H = (LAS unsigned*)(lds + HIST_OFF + wave * 1024);
                if (ncl == 1) select_row<1>(SC, BM, H, qq, nch, lane);
                else if (ncl == 2) select_row<2>(SC, BM, H, qq, nch, lane);
                else if (ncl == 3) select_row<3>(SC, BM, H, qq, nch, lane);
                else select_row<4>(SC, BM, H, qq, nch, lane);
            }
        }
#endif
        __syncthreads();
    } else {
        LOAD_QB();
        for (int i = tid; i < 32 * (L >> 5); i += NWAVES * 64) { const int r = i / (L >> 5), d = i % (L >> 5); ((LAS unsigned*)(BM + r * BM_ROW))[d] = 0u; }
        __syncthreads();
    }
#ifndef NO_PASSB
#pragma unroll 1
    for (int repb_ = 0; repb_ < ATTN_REP_B; ++repb_) {
        asm volatile("" ::: "memory");
        const int hp = wave & 3, par = wave >> 2, kvh = hp >> 1;
        constexpr int SLOT = 16384;
        const LAS unsigned char* ring = lds;
        const int pkv = wave >> 2, psub = wave & 3, P = psub * 64 + lane;
        const int ks_row = P >> 3, ks_c = (P & 7) ^ (ks_row & 7);
        const int vs_row = P >> 2, vs_c = (P & 3) ^ ((vs_row >> 2) & 3);
        const bf16_t* ksrc = Kb + (size_t)pkv * SL * 64 + ks_row * 64 + ks_c * 8;
        const bf16_t* vsrc = Vt + (size_t)pkv * 64 * SL + vs_row * 32 + vs_c * 8;
        const unsigned kdst = (unsigned)(pkv * 4096 + psub * 1024), vdst = (unsigned)(8192 + pkv * 4096 + psub * 1024);
#define PB_DMA(kt_) do { const int t_ = (kt_) < ntiles ? (kt_) : ntiles - 1; const int so_ = ((kt_) & 7) * SLOT; \
            __builtin_amdgcn_global_load_lds((const unsigned*)(ksrc + (size_t)t_ * 2048), (LAS unsigned*)(lds + so_ + kdst), 16, 0, 0); \
            __builtin_amdgcn_global_load_lds((const unsigned*)(vsrc + (size_t)t_ * 2048), (LAS unsigned*)(lds + so_ + vdst), 16, 0, 0); } while (0)
        const int kro = kvh * 4096 + q * 128;
        const int vro = 8192 + kvh * 4096 + q * 64;
        const LAS unsigned char* brow = BM + q * BM_ROW;
        f32x16 oa0, oa1, ob0, ob1;
#pragma unroll
        for (int r = 0; r < 16; ++r) { oa0[r] = 0.f; oa1[r] = 0.f; ob0[r] = 0.f; ob1[r] = 0.f; }
        float lsa = 0.f, lsb = 0.f;
#define PB_TILE(kt_) do { const LAS unsigned char* sb_ = ring + ((kt_) & 7) * SLOT; bf16x8 kf_[4], vf_[2][2]; \
            _Pragma("unroll") for (int ks = 0; ks < 4; ++ks) kf_[ks] = *(const LAS bf16x8*)(sb_ + kro + (((2 * ks + hh) ^ (q & 7)) << 4)); \
            _Pragma("unroll") for (int db = 0; db < 2; ++db) _Pragma("unroll") for (int s2 = 0; s2 < 2; ++s2) \
                vf_[db][s2] = *(const LAS bf16x8*)(sb_ + vro + db * 2048 + (((2 * s2 + hh) ^ ((q >> 2) & 3)) << 4)); \
            const unsigned wm_ = *(const LAS unsigned*)(brow + 4 * (kt_)) >> (4 * hh); \
            f32x16 ci_; \
            _Pragma("unroll") for (int g = 0; g < 4; ++g) _Pragma("unroll") for (int i = 0; i < 4; ++i) \
                { int t_; asm("v_bfe_i32 %0, %1, %2, 1" : "=v"(t_) : "v"(wm_), "n"(8 * g + i)); unsigned u_; asm("v_and_b32 %0, 0xff800000, %1" : "=v"(u_) : "v"(t_)); ci_[4 * g + i] = __builtin_bit_cast(float, u_); } \
            asm volatile("s_nop 1" : "+v"(ci_));        \
            f32x16 ca_ = ci_, cb_ = ci_; \
            _Pragma("unroll") for (int ks = 0; ks < 4; ++ks) ca_ = MFMA32(kf_[ks], qb[0][ks], ca_); \
            _Pragma("unroll") for (int ks = 0; ks < 4; ++ks) cb_ = MFMA32(kf_[ks], qb[1][ks], cb_); \
            { float p_[16]; _Pragma("unroll") for (int r = 0; r < 16; ++r) { p_[r] = __builtin_amdgcn_exp2f(ca_[r]); lsa += p_[r]; } \
              u32x4 pw0_, pw1_; \
              pw0_.x = pk2(p_[0], p_[1]); pw0_.y = pk2(p_[2], p_[3]); pw0_.z = pk2(p_[4], p_[5]); pw0_.w = pk2(p_[6], p_[7]); \
              pw1_.x = pk2(p_[8], p_[9]); pw1_.y = pk2(p_[10], p_[11]); pw1_.z = pk2(p_[12], p_[13]); pw1_.w = pk2(p_[14], p_[15]); \
              const bf16x8 pb0_ = __builtin_bit_cast(bf16x8, pw0_), pb1_ = __builtin_bit_cast(bf16x8, pw1_); \
              oa0 = MFMA32(vf_[0][0], pb0_, oa0); oa0 = MFMA32(vf_[0][1], pb1_, oa0); \
              oa1 = MFMA32(vf_[1][0], pb0_, oa1); oa1 = MFMA32(vf_[1][1], pb1_, oa1); } \
            { float p_[16]; _Pragma("unroll") for (int r = 0; r < 16; ++r) { p_[r] = __builtin_amdgcn_exp2f(cb_[r]); lsb += p_[r]; } \
              u32x4 pw0_, pw1_; \
              pw0_.x = pk2(p_[0], p_[1]); pw0_.y = pk2(p_[2], p_[3]); pw0_.z = pk2(p_[4], p_[5]); pw0_.w = pk2(p_[6], p_[7]); \
              pw1_.x = pk2(p_[8], p_[9]); pw1_.y = pk2(p_[10], p_[11]); pw1_.z = pk2(p_[12], p_[13]); pw1_.w = pk2(p_[14], p_[15]); \
              const bf16x8 pb0_ = __builtin_bit_cast(bf16x8, pw0_), pb1_ = __builtin_bit_cast(bf16x8, pw1_); \
              ob0 = MFMA32(vf_[0][0], pb0_, ob0); ob0 = MFMA32(vf_[0][1], pb1_, ob0); \
              ob1 = MFMA32(vf_[1][0], pb0_, ob1); ob1 = MFMA32(vf_[1][1], pb1_, ob1); } } while (0)
        asm volatile("s_waitcnt vmcnt(0) lgkmcnt(0)" ::: "memory");
        __builtin_amdgcn_s_barrier();
        PB_DMA(0); PB_DMA(1); PB_DMA(2); PB_DMA(3); PB_DMA(4);
        for (int kt = 0; kt < ntiles; kt += 2) {
            asm volatile("s_waitcnt vmcnt(6)" ::: "memory");
            __builtin_amdgcn_s_barrier(); asm volatile("" ::: "memory");
            PB_DMA(kt + 5); PB_DMA(kt + 6);
            if (kt + par < ntiles) PB_TILE(kt + par);
        }
#undef PB_TILE
        asm volatile("s_waitcnt vmcnt(0) lgkmcnt(0)" ::: "memory");
        __builtin_amdgcn_s_barrier(); asm volatile("" ::: "memory");
#undef PB_DMA
        lsa += __shfl_xor(lsa, 32); lsb += __shfl_xor(lsb, 32);
        LAS float* xch = (LAS float*)lds + (size_t)hp * (66 * 64) + lane;
        if (par == 1) {
#pragma unroll
            for (int r = 0; r < 16; ++r) { xch[(r) * 64] = oa0[r]; xch[(16 + r) * 64] = oa1[r]; xch[(32 + r) * 64] = ob0[r]; xch[(48 + r) * 64] = ob1[r]; }
            xch[64 * 64] = lsa; xch[65 * 64] = lsb;
        }
        asm volatile("s_waitcnt lgkmcnt(0)" ::: "memory");
        __builtin_amdgcn_s_barrier(); asm volatile("" ::: "memory");
        if (par == 0) {
#pragma unroll
            for (int r = 0; r < 16; ++r) { oa0[r] += xch[(r) * 64]; oa1[r] += xch[(16 + r) * 64]; ob0[r] += xch[(32 + r) * 64]; ob1[r] += xch[(48 + r) * 64]; }
            lsa += xch[64 * 64]; lsb += xch[65 * 64];
            const float inva = 1.0f / lsa, invb = 1.0f / lsb;
            if (q < nq) {
                bf16_t* op = (bf16_t*)(ws + WS_A4) + (size_t)(m0 + q) * DM + 512 + 128 * hp + 4 * hh;
#pragma unroll
                for (int g = 0; g < 4; ++g) {
                    u32x2 w0, w1;
                    w0.x = pk2(oa0[4 * g] * inva, oa0[4 * g + 1] * inva); w0.y = pk2(oa0[4 * g + 2] * inva, oa0[4 * g + 3] * inva);
                    w1.x = pk2(oa1[4 * g] * inva, oa1[4 * g + 1] * inva); w1.y = pk2(oa1[4 * g + 2] * inva, oa1[4 * g + 3] * inva);
                    *(u32x2*)(op + 8 * g) = w0; *(u32x2*)(op + 32 + 8 * g) = w1;
                    w0.x = pk2(ob0[4 * g] * invb, ob0[4 * g + 1] * invb); w0.y = pk2(ob0[4 * g + 2] * invb, ob0[4 * g + 3] * invb);
                    w1.x = pk2(ob1[4 * g] * invb, ob1[4 * g + 1] * invb); w1.y = pk2(ob1[4 * g + 2] * invb, ob1[4 * g + 3] * invb);
                    *(u32x2*)(op + 64 + 8 * g) = w0; *(u32x2*)(op + 64 + 32 + 8 * g) = w1;
                }
            }
        }
    }
#endif
    __syncthreads();
}

#define XB_TMO      128
#define XB_XCNT(j)  (256  + 64 * (j))
#define XB_XSUB(j)  (1280 + 64 * (j))
#define XB_XGEN(j)  (2304 + 64 * (j))
#define XB_TOP      3328
#define XB_TOPGEN   3392
#define XCD_BAR_WORDS 3456
#define XB_SPIN_CAP (1u << 18)
__device__ __forceinline__ unsigned xb_ld(unsigned* p)              { return __hip_atomic_load(p, __ATOMIC_RELAXED, __HIP_MEMORY_SCOPE_AGENT); }
__device__ __forceinline__ unsigned xb_add(unsigned* p, unsigned v) { return __hip_atomic_fetch_add(p, v, __ATOMIC_RELAXED, __HIP_MEMORY_SCOPE_AGENT); }
__device__ __forceinline__ unsigned xb_xcc_id() { return (unsigned)__builtin_amdgcn_s_getreg((3 << 11) | 20) & 0xFu; }
#define XB_SPIN(cond, bar) do { unsigned _sp = 0; while (cond) { __builtin_amdgcn_s_sleep(1); \
    if ((++_sp & 255u) == 0u) { if (xb_ld(&(bar)[XB_TMO])) break; if (_sp > XB_SPIN_CAP) { atomicAdd(&(bar)[XB_TMO], 1u); break; } } } } while (0)
struct XcdBarrier { unsigned* bar; unsigned x; volatile LAS unsigned* st; int wave; };
__device__ __forceinline__ XcdBarrier xcd_barrier_post(unsigned* bar, volatile LAS unsigned* st) {
    XcdBarrier b; b.bar = bar; b.x = xb_xcc_id(); b.st = st;
    if (threadIdx.x == 0) (void)xb_add(&bar[XB_XCNT(b.x)], 1u);
    return b;
}
__device__ __forceinline__ void xcd_barrier_complete(unsigned* bar, unsigned x, unsigned& nloc, unsigned& nx) {
    const unsigned G = gridDim.x * gridDim.y * gridDim.z;
    unsigned sum, cnt, mine, sp = 0u;
    for (;;) {
        sum = 0u; cnt = 0u; mine = 0u;
#pragma unroll
        for (unsigned j = 0; j < 16; ++j) { const unsigned c = xb_ld(&bar[XB_XCNT(j)]); sum += c; cnt += (c > 0u) ? 1u : 0u; mine = (j == x) ? c : mine; }
        if (sum == G) break;
        __builtin_amdgcn_s_sleep(1);
        if ((++sp & 255u) == 0u) { if (xb_ld(&bar[XB_TMO])) break; if (sp > XB_SPIN_CAP) { atomicAdd(&bar[XB_TMO], 1u); break; } }
    }
    nloc = mine > 0u ? mine : 1u; nx = cnt > 0u ? cnt : 1u;
}
__device__ __forceinline__ void xcd_barrier(const XcdBarrier& b) {
    asm volatile("s_waitcnt vmcnt(0)" ::: "memory");
    __syncthreads();
    if (b.wave == 0 && lane_now() == 0) {
        unsigned* bar = b.bar;
        __builtin_amdgcn_s_waitcnt(0);
        unsigned nloc = b.st[0], nx = b.st[1];
        if (nloc == 0u) { xcd_barrier_complete(bar, b.x, nloc, nx); b.st[0] = nloc; b.st[1] = nx; }
        const unsigned old = xb_add(&bar[XB_XSUB(b.x)], 1u);
        const unsigned gen = old / nloc;
        if (old + 1u == (gen + 1u) * nloc) {
            __builtin_amdgcn_fence(__ATOMIC_RELEASE, "agent");
            asm volatile("s_waitcnt vmcnt(0)" ::: "memory");
            const unsigned og = xb_add(&bar[XB_TOP], 1u);
            const unsigned tg = og / nx;
            if (og + 1u == (tg + 1u) * nx) xb_add(&bar[XB_TOPGEN], 1u);
            else XB_SPIN(xb_ld(&bar[XB_TOPGEN]) == tg, bar);
            __builtin_amdgcn_fence(__ATOMIC_ACQUIRE, "agent");
            xb_add(&bar[XB_XGEN(b.x)], 1u);
            asm volatile("s_waitcnt vmcnt(0)" ::: "memory");
        } else {
            XB_SPIN(xb_ld(&bar[XB_XGEN(b.x)]) == gen, bar);
            __builtin_amdgcn_fence(__ATOMIC_ACQUIRE, "agent");
            asm volatile("s_waitcnt vmcnt(0)" ::: "memory");
        }
    }
    __syncthreads();
}
constexpr int CW_BAR = 4096;

template <bool COOP>
__global__ void __launch_bounds__(NWAVES * 64, 2) fwd_kernel(Args args) {
    extern __shared__ __attribute__((aligned(16))) unsigned char lds_raw[];
    LAS unsigned char* lds = (LAS unsigned char*)lds_raw;
    const int wave = __builtin_amdgcn_readfirstlane((int)threadIdx.x >> 6);
#define lane lane_now()
#define tid (wave * 64 + lane_now())
    const int G = gridDim.x, bx = blockIdx.x;
    const int vcu = (G % 8 == 0) ? (bx % 8) * (G / 8) + bx / 8 : bx;
    unsigned char* ws = args.ws;
    float* out = args.out;
    const int lo = args.ph_lo, hi = args.ph_hi;
#ifndef PHASE_MASK
#define PHASE_MASK 0x1ff
#endif
#define IN(k) (((PHASE_MASK >> (k)) & 1) && lo <= (k) && (k) < hi)
#define SEAM(k) do { if (COOP) { if (IN(k) && IN((k) + 1)) xcd_barrier(xbar); } } while (0)
    XcdBarrier xbar; xbar.bar = (unsigned*)(ws + WS_CTL) + CW_BAR; xbar.x = 0; xbar.st = nullptr;
    if (COOP) {
        volatile LAS unsigned* st = (volatile LAS unsigned*)(lds + LDS_MISC + 16);
        if (tid < 2) st[tid] = 0u;
        __syncthreads();
        xbar = xcd_barrier_post((unsigned*)(ws + WS_CTL) + CW_BAR, st);
    }
    xbar.wave = wave;

#define AB ((bf16_t*)(ws + WS_AB))
#define R1 ((bf16_t*)(ws + WS_R1))
#define A4 ((bf16_t*)(ws + WS_A4))
#define PA ((float*)(ws + WS_PA))
#define PB ((float*)(ws + WS_PB))
#define PC ((float*)(ws + WS_PC))
#define PSB ((float*)(ws + WS_PSB))
#define PSC ((float*)(ws + WS_PSC))

    if (IN(0)) { p0_prologue(args, lds, vcu, G, tid, wave, lane); }
    SEAM(0);
    if (IN(1)) {
        pg8::Gemm g{(const bf16_t*)(ws + WS_XQ), (const bf16_t*)(ws + WS_W1Q), MP, NFF2, DM / 2}; pg8::StaticOrder S; S.init(MP, NFF2, G, bx);
        EpiSwiGLUQ<false> E{R1, (const float*)(ws + WS_RM1), (const float*)(ws + WS_SB1)};
        sample_swiglu((const bf16_t*)(ws + WS_XQ), (const bf16_t*)(ws + WS_W1Q), R1, (const float*)(ws + WS_RM1), (const float*)(ws + WS_SB1), G / 2, G, bx, lds, wave, lane);
        if (bx >= G / 2) { __syncthreads(); for (int it = bx - G / 2; it < N_QGU; it += G - G / 2) quant_gu(args, 1, it, lds, tid, lane, wave); __syncthreads(); }
        pg8::gemm_phase<EpiSwiGLUQ<false>, pg8::StaticOrder, true, true, 1>(lds, g, S, E, wave);
    }
    SEAM(1);
    if (IN(2)) {
        pg8::Gemm g{R1, (const bf16_t*)(ws + WS_W2T), MP, DM, DFF}; pg8::StaticOrder S; S.init(MP, DM, G, bx);
        EpiResid<1, false, true, true> E{nullptr, nullptr, AB, PB, AB};
        if (bx & 1) {
            sample_resid<1, false, true>(R1 + (size_t)MP * DFF, DFF, (const bf16_t*)(ws + WS_W2T), nullptr, nullptr, 0.5f, AB + (size_t)MP * DM, PSB, G, bx, lds, wave, lane);
            __syncthreads(); }
        pg8::gemm_phase<EpiResid<1, false, true, true>, pg8::StaticOrder, false, true>(lds, g, S, E, wave);
        if (!(bx & 1))
            sample_resid<1, false, true>(R1 + (size_t)MP * DFF, DFF, (const bf16_t*)(ws + WS_W2T), nullptr, nullptr, 0.5f, AB + (size_t)MP * DM, PSB, G, bx, lds, wave, lane);
    }
    SEAM(2);
    if (IN(3)) {
        pg8::Gemm g{AB, (const bf16_t*)(ws + WS_W3T), MP, NZ, DM}; Order3 S; S.init(MP, NZ, G, bx);
        EpiZF E{ws, out, PB, args.in[13], args.in[14], args.in[15]};
        pg8::gemm_phase<EpiZF, Order3, true, true>(lds, g, S, E, wave);
        sample_z(AB, (const bf16_t*)(ws + WS_W3T), R1, (float*)(ws + WS_ZL), PSB, G, bx, lds, wave, lane);
    }
    SEAM(3);
    if (IN(4)) {
        unsigned* qhead = (unsigned*)(ws + WS_CTL) + CW_QUEUE + 64 * args.pad;
        volatile LAS int* slot = (volatile LAS int*)(lds + LDS_MISC);
        if (bx < 8) { for (int r = wave; r < TSQ; r += NWAVES) pz_row(args, MP + TSQ * bx + r, lane); __syncthreads(); }
        for (int iter = 0;; ++iter) {
            int e;
            const int nstatic = G > 8 ? (G - 8 < N_UNITS - 8 ? G - 8 : N_UNITS - 8) : 0;
            if (iter == 0 && bx < 8) e = 256 + bx;
            else {
                if (iter == 0 && bx - 8 < nstatic) e = bx - 8;
                else {
                    if (tid == 0) slot[0] = (int)atomicAdd(qhead, 1u);
                    __syncthreads();
                    e = nstatic + slot[0];
                    __syncthreads();
                }
#if CONV_TAIL
                if (e >= N_UNITS - 8) {
                    const int ci = e - (N_UNITS - 8);
                    if (ci >= MP / 32) break;
                    conv_rows4(args, 32 * ci + wave, lane);
                    continue;
                }
#else
                if (e >= N_UNITS - 8) break;
#endif
                e = e < 256 ? e : e + 8;
            }
            attn_unit(args, lds, e, tid, wave, lane);
        }
    }
    SEAM(4);
    if (IN(5)) {
        pg8::Gemm g{A4, (const bf16_t*)(ws + WS_W4T), MP, DM, DM}; pg8::StaticOrder S; S.init(MP, DM, G, bx);
        EpiResid<1, false, true, false, false, false> E{nullptr, nullptr, AB, nullptr, AB};
        if (bx & 1) {
            sample_resid<1, false, true>(A4 + (size_t)MP * DM, DM, (const bf16_t*)(ws + WS_W4T), nullptr, nullptr, 1.0f, AB + (size_t)MP * DM, nullptr, G, bx, lds, wave, lane);
            __syncthreads(); }
        pg8::gemm_phase<EpiResid<1, false, true, false, false, false>, pg8::StaticOrder, false, true>(lds, g, S, E, wave);
        if (!(bx & 1))
            sample_resid<1, false, true>(A4 + (size_t)MP * DM, DM, (const bf16_t*)(ws + WS_W4T), nullptr, nullptr, 1.0f, AB + (size_t)MP * DM, nullptr, G, bx, lds, wave, lane);
    }
    SEAM(5);
    if (IN(6)) {
        for (int g8 = vcu * NWAVES + wave; g8 < MP / 8; g8 += G * NWAVES) {
            quant_rows<4>(AB, ws + WS_XQ, (float*)(ws + WS_RM2), 8 * g8, 4, lane); quant_rows<4>(AB, ws + WS_XQ, (float*)(ws + WS_RM2), 8 * g8 + 4, 4, lane); }
        for (int g4 = vcu * NWAVES + wave; g4 < MS / 4; g4 += G * NWAVES) quant_rows<4>(AB, ws + WS_XQ, (float*)(ws + WS_RM2), MP + 4 * g4, 4, lane);
    }
    SEAM(6);
    if (IN(7)) {
        pg8::Gemm g{(const bf16_t*)(ws + WS_XQ), (const bf16_t*)(ws + WS_W5Q), MP, NFF2, DM / 2}; pg8::StaticOrder S; S.init(MP, NFF2, G, bx);
        EpiSwiGLUQ<true> E{R1, (const float*)(ws + WS_RM2), (const float*)(ws + WS_SB5)};
        sample_swiglu<true>((const bf16_t*)(ws + WS_XQ), (const bf16_t*)(ws + WS_W5Q), R1, (const float*)(ws + WS_RM2), (const float*)(ws + WS_SB5), G / 2, G, bx, lds, wave, lane);
        if (bx >= G / 2) { __syncthreads(); for (int it = bx - G / 2; it < N_QDN; it += G - G / 2) quant_dn_item(args.in[20], ws + WS_W6F, (float*)(ws + WS_SB6), 16 * it, lds, tid, lane, wave); __syncthreads(); }
        pg8::gemm_phase<EpiSwiGLUQ<true>, pg8::StaticOrder, true, true, 1>(lds, g, S, E, wave);
    }
    SEAM(7);
    if (IN(8)) {
        pg8::Gemm g{R1, (const bf16_t*)(ws + WS_W6F), MP, DM, DFF / 2}; pg8::StaticOrder S; S.init(MP, DM, G, bx);
        EpiResid<1, true, false, true, true> E{nullptr, out + O_Y, AB, nullptr, AB, (const float*)(ws + WS_SB6)};
        if (bx & 1) {
            sample_resid_f8((const unsigned char*)R1 + (size_t)MP * DFF, ws + WS_W6F, (const float*)(ws + WS_SB6), out + O_Y + (size_t)MP * DM, AB + (size_t)MP * DM, G, bx, lds, wave, lane);
            __syncthreads(); }
        pg8::gemm_phase<EpiResid<1, true, false, true, true>, pg8::StaticOrder, false, true, 2>(lds, g, S, E, wave);
        if (!(bx & 1))
            sample_resid_f8((const unsigned char*)R1 + (size_t)MP * DFF, ws + WS_W6F, (const float*)(ws + WS_SB6), out + O_Y + (size_t)MP * DM, AB + (size_t)MP * DM, G, bx, lds, wave,
                            lane_now());
    }
#undef lane
#undef tid
#undef IN
#undef SEAM
#undef AB
#undef R1
#undef A4
#undef PA
#undef PB
#undef PC
#undef PSB
#undef PSC
}

constexpr int N_PHASES = 9;
#ifndef MK_ONE_LAUNCH
#define MK_ONE_LAUNCH 1
#endif
#ifndef MK_COOP_LAUNCH
#define MK_COOP_LAUNCH 0
#endif
extern "C" void kernel_launch(void* const* d_in, const int* in_sizes, int n_in, void* d_out, int out_size, void* d_ws, size_t ws_size, hipStream_t stream) {
    static int grid = 0;
    if (grid == 0) {
        if (n_in != 21 || (size_t)out_size != O_END || ws_size < WS_END) { fprintf(stderr, "kernel_launch: unexpected sizes: n_in %d out %d ws %zu\n", n_in, out_size, ws_size); grid = -1; return; }
        int dev = 0, cus = 0;
        if (hipGetDevice(&dev) != hipSuccess || hipDeviceGetAttribute(&cus, hipDeviceAttributeMultiprocessorCount, dev) != hipSuccess) { grid = -1; return; }
        if (hipFuncSetAttribute((const void*)fwd_kernel<false>, hipFuncAttributeMaxDynamicSharedMemorySize, LDS_BYTES) != hipSuccess) { fprintf(stderr, "kernel_launch: hipFuncSetAttribute failed\n"); grid = -1; return; }
        if (hipFuncSetAttribute((const void*)fwd_kernel<true>, hipFuncAttributeMaxDynamicSharedMemorySize, LDS_BYTES) != hipSuccess) { fprintf(stderr, "kernel_launch: hipFuncSetAttribute failed\n"); grid = -1; return; }
        int per_cu = 0;
        if (hipOccupancyMaxActiveBlocksPerMultiprocessor(&per_cu, (const void*)fwd_kernel<true>, NWAVES * 64, LDS_BYTES) != hipSuccess || per_cu < 1) { fprintf(stderr, "kernel_launch: occupancy query says %d\n", per_cu); per_cu = 1; }
        (void)hipGetLastError();
        grid = cus;
    }
    if (grid < 0) return;
    (void)hipMemsetAsync((char*)d_ws + WS_CTL, 0, CTL_BYTES, stream);
    Args a{};
    for (int i = 0; i < 21; ++i) a.in[i] = (const float*)d_in[i];
    a.out = (float*)d_out; a.ws = (unsigned char*)d_ws;
#if MK_ONE_LAUNCH
    a.ph_lo = 0; a.ph_hi = N_PHASES; a.coop = 1;
#if MK_COOP_LAUNCH
    void* kargs[] = {&a};
    hipError_t e = hipLaunchCooperativeKernel((const void*)fwd_kernel<true>, dim3(grid), dim3(NWAVES * 64), kargs, LDS_BYTES, stream);
    if (e != hipSuccess) fprintf(stderr, "cooperative launch failed: %s (grid %d)\n", hipGetErrorString(e), grid);
#else
    hipLaunchKernelGGL(fwd_kernel<true>, dim3(grid), dim3(NWAVES * 64), LDS_BYTES, stream, a);
#endif
#else
    for (int p = 0; p < N_PHASES; ++p) {
        a.ph_lo = p; a.ph_hi = p + 1; a.coop = 0;
        for (int rep = 0; rep < 1 + ((REPEAT_MASK >> p) & 1); ++rep) {
            a.pad = rep;
            hipLaunchKernelGGL(fwd_kernel<false>, dim3(grid), dim3(NWAVES * 64), LDS_BYTES, stream, a);
        }
    }
#endif
}
```

```cpp
#include <hip/hip_runtime.h>
#include <cstdio>
#include <cstdint>
#ifndef CONV_TAIL
#define CONV_TAIL 1
#endif
#ifndef REPEAT_MASK
#define REPEAT_MASK 0
#endif

namespace pg8 {
#define PG8_LAS __attribute__((address_space(3)))
typedef unsigned short bf16_t;
typedef short bf16x8 __attribute__((ext_vector_type(8)));
typedef float f32x4 __attribute__((ext_vector_type(4)));
typedef unsigned u32x4 __attribute__((ext_vector_type(4)));
constexpr int BM = 256, BK = 64, HALF = 128, HTB = HALF * BK * 2, STAGE_BYTES = 8 * HTB, NXCD = 8, WGM = 8;

__host__ __device__ __forceinline__ int lds_byte(int r, int c) { const int st = (r >> 4) * 2 + (c >> 5), rr = r & 15, cc = c & 31, ob = rr * 64 + cc * 2; return st * 1024 + (ob ^ (((ob >> 9) & 1) << 5)); }
__host__ __device__ __forceinline__ void stage_rc(int b, int& R, int& C) { const int st = b / 1024, sb = b % 1024, swz = sb ^ (((sb >> 9) & 1) << 5); R = (st >> 1) * 16 + swz / 64; C = (st & 1) * 32 + (swz % 64) / 2; }
__host__ __device__ __forceinline__ int perm32(int rho) { const int n = rho >> 4, i = rho & 15; return 8 * (i >> 2) + 4 * n + (i & 3); }

struct Unit { int pm, pn; };
struct Gemm { const bf16_t* A; const bf16_t* Bt; int M, N, K; };

struct StaticOrder {
    int nM, nN, nwg, G, c;
    __host__ __device__ void init(int M, int N, int G_, int c_) { nM = M / BM; nN = N / BM; nwg = nM * nN; G = G_; c = c_; }
    __host__ __device__ bool next(int i, Unit& u) const {
        const long L = (long)i * G + c; if (L >= nwg) return false;
        int wgid = (int)L; { const int q = nwg / NXCD, r = nwg % NXCD, xcd = wgid % NXCD, off = wgid / NXCD; wgid = (xcd < r ? xcd * (q + 1) : r * (q + 1) + (xcd - r) * q) + off; }
        const int nig = WGM * nN, gid = wgid / nig, fm = gid * WGM, gsz = (nM - fm) < WGM ? (nM - fm) : WGM;
        u.pm = fm + ((wgid % nig) % gsz); u.pn = (wgid % nig) / gsz; return true;
    }
    __device__ __forceinline__ void a_ready(const Unit&) const {}
    __device__ __forceinline__ void done(const Unit&) const {}
};

__device__ __forceinline__ unsigned cvt_pk_bf16(float lo, float hi) { unsigned r; asm volatile("v_cvt_pk_bf16_f32 %0, %1, %2" : "=v"(r) : "v"(lo), "v"(hi)); return r; }

typedef int i32x4 __attribute__((ext_vector_type(4)));
template <bool I8> __device__ __forceinline__ f32x4 mma16(const bf16x8 b, const bf16x8 a, const f32x4 c) {
    if constexpr (I8) return (f32x4)__builtin_amdgcn_mfma_i32_16x16x64_i8((i32x4)b, (i32x4)a, (i32x4)c, 0, 0, 0);
    else return __builtin_amdgcn_mfma_f32_16x16x32_bf16(b, a, c, 0, 0, 0);
}
typedef int i32x8 __attribute__((ext_vector_type(8)));
__device__ __forceinline__ f32x4 mma128(const i32x8 b8, const i32x8 a8, const f32x4 c) {
    return __builtin_amdgcn_mfma_scale_f32_16x16x128_f8f6f4(b8, a8, c, 0, 0, 0, 0, 0, 0);
}
__device__ __forceinline__ i32x8 ld8(const PG8_LAS unsigned char* p) {
    const i32x4 lo = *(const PG8_LAS i32x4*)p, hi = *(const PG8_LAS i32x4*)(p + 1024);
    return __builtin_shufflevector(lo, hi, 0, 1, 2, 3, 4, 5, 6, 7);
}
__device__ __forceinline__ const char* gptr32(const void* base, unsigned off) {
    const unsigned long long b = (unsigned long long)base; unsigned lo, hi;
    asm volatile("v_add_co_u32_e64 %0, vcc, %2, %3\n\tv_mov_b32 %1, %4\n\tv_addc_co_u32_e32 %1, vcc, 0, %1, vcc" : "=&v"(lo), "=&v"(hi) : "s"((unsigned)b), "v"(off), "s"((unsigned)(b >> 32)) : "vcc");
    return (const char*)(((unsigned long long)hi << 32) | lo);
}
template <class Epi, class Sched, bool ALIGN_EPI = false, bool SP2 = false, int MODE = 0>
__device__ __forceinline__ void gemm_phase(PG8_LAS unsigned char* lds, const Gemm g, const Sched S, const Epi E, const int wid  ) {
    int lane; asm volatile("v_mbcnt_lo_u32_b32 %0, -1, 0\n\tv_mbcnt_hi_u32_b32 %0, -1, %0" : "=v"(lane));
    const int tid = wid * 64 + lane, wr = wid >> 2, wc = wid & 3, fr = lane & 15, fq = lane >> 4;
    const int K = g.K, nt = K / BK;
    unsigned voffA[2], voffB[2];
#pragma unroll
    for (int i = 0; i < 2; ++i) { int R, C; stage_rc(tid * 16 + i * 8192, R, C); const int Rb = Epi::PERM ? ((R & ~31) + perm32(R & 31)) : R;
        voffA[i] = (unsigned)(R * K + C) * 2u; voffB[i] = (unsigned)(Rb * K + C) * 2u; }
    const size_t kstep = (size_t)(BK * 2);
    const size_t hstep = (size_t)HALF * K * 2;
    const size_t tstep = 2 * hstep;
    const unsigned ldsw = (unsigned)wid * 1024u;
    const int aoff = lds_byte(wr * 64 + fr, fq * 8), boff = lds_byte(wc * 32 + fr, fq * 8);
#define PG8_SA(b, h) (((b) * 2 + (h)) * HTB)
#define PG8_SB(b, h) ((4 + (b) * 2 + (h)) * HTB)
#define PG8_STAGE(bufoff, gbase, voff) do { _Pragma("unroll") for (int _i = 0; _i < 2; ++_i) { \
        if constexpr (MODE == 2) __builtin_amdgcn_global_load_lds((const unsigned*)gptr32((const char*)(gbase) + (size_t)_i * 128 * K, (voff)[0]), (PG8_LAS unsigned*)(lds + (bufoff) + ldsw + _i * 8192), 16, 0, 0);   \
        else __builtin_amdgcn_global_load_lds((const unsigned*)((const char*)(gbase) + (voff)[_i]), (PG8_LAS unsigned*)(lds + (bufoff) + ldsw + _i * 8192), 16, 0, 0); } } while (0)
#define PG8_MMAF(ai, bj, At, Bt) do { __builtin_amdgcn_s_setprio(1); _Pragma("unroll") for (int m = 0; m < 4; ++m) _Pragma("unroll") for (int n = 0; n < 2; ++n) \
        acc[ai][bj][m][n] = mma128(Bt##8[n], At##8[m], acc[ai][bj][m][n]); __builtin_amdgcn_s_setprio(0); } while (0)
#define PG8_MMA2(ai, At, b, h) do { if constexpr (MODE == 2) { PG8_MMAF(ai, 0, At, B0); PG8_MMAF(ai, 1, At, B1); } \
        else { PG8_MMA(ai, 0, At, B0); PG8_MMA(ai, 1, At, B1); } } while (0)
#define PG8_LDA(dst, b, h) do { if constexpr (MODE == 2) { _Pragma("unroll") for (int m = 0; m < 4; ++m) dst##8[m] = ld8(lds + PG8_SA(b, h) + aoff + m * 2048); } \
        else { _Pragma("unroll") for (int m = 0; m < 4; ++m) _Pragma("unroll") for (int k = 0; k < 2; ++k) dst[m][k] = *(const PG8_LAS bf16x8*)(lds + PG8_SA(b, h) + aoff + m * 2048 + k * 1024); } } while (0)
#define PG8_LDB(dst, b, h) do { if constexpr (MODE == 2) { _Pragma("unroll") for (int n = 0; n < 2; ++n) dst##8[n] = ld8(lds + PG8_SB(b, h) + boff + n * 2048); } \
        else { _Pragma("unroll") for (int n = 0; n < 2; ++n) _Pragma("unroll") for (int k = 0; k < 2; ++k) dst[n][k] = *(const PG8_LAS bf16x8*)(lds + PG8_SB(b, h) + boff + n * 2048 + k * 1024); } } while (0)
#define PG8_MMA(ai, bj, At, Bt) do { __builtin_amdgcn_s_setprio(1); _Pragma("unroll") for (int m = 0; m < 4; ++m) _Pragma("unroll") for (int n = 0; n < 2; ++n) { \
        if constexpr (MODE == 2) { static_assert(MODE != 2 || SP2, "fp8 mode: SP2 schedule only"); } \
        else { _Pragma("unroll") for (int k = 0; k < 2; ++k) acc[ai][bj][m][n] = mma16<MODE == 1>(Bt[n][k], At[m][k], acc[ai][bj][m][n]); } } __builtin_amdgcn_s_setprio(0); } while (0)
#define PG8_WAIT_V(n) asm volatile("s_waitcnt vmcnt(" #n ")" ::: "memory")
#define PG8_WAIT_L(n) asm volatile("s_waitcnt lgkmcnt(" #n ")" ::: "memory")
#define PG8_BAR __builtin_amdgcn_s_barrier()
#define PG8_SCHED __builtin_amdgcn_sched_barrier(0)
    Unit cur, nxt; int ui = 0;
    if (!S.next(0, cur)) return;
    f32x4 acc[2][2][4][2];
#pragma unroll
    for (int a = 0; a < 2; ++a)
#pragma unroll
        for (int b = 0; b < 2; ++b)
#pragma unroll
            for (int m = 0; m < 4; ++m)
#pragma unroll
                for (int n = 0; n < 2; ++n) acc[a][b][m][n] = (f32x4){0.f, 0.f, 0.f, 0.f};
    bf16x8 At[4][2], B0[2][2], B1[2][2];
    i32x8 At8[4], B08[2], B18[2];
    const char* cA = (const char*)g.A + (size_t)cur.pm * tstep; const char* cB = (const char*)g.Bt + (size_t)cur.pn * tstep;
    S.a_ready(cur);
    typename Epi::Pre pre;
    if constexpr (Epi::PREF) pre = E.prefetch(cur, wr, wc, fr, fq);
    if constexpr (SP2) {
        PG8_STAGE(PG8_SB(0, 0), cB, voffB); PG8_STAGE(PG8_SB(0, 1), cB + hstep, voffB); PG8_STAGE(PG8_SA(0, 0), cA, voffA); PG8_STAGE(PG8_SA(0, 1), cA + hstep, voffA);
        if (wr == 1) PG8_BAR;
        PG8_WAIT_V(2); PG8_BAR;
        PG8_STAGE(PG8_SB(1, 0), cB + kstep, voffB); PG8_STAGE(PG8_SA(1, 0), cA + kstep, voffA); PG8_STAGE(PG8_SB(1, 1), cB + hstep + kstep, voffB);
        PG8_WAIT_V(6); PG8_BAR;
    } else {
        PG8_STAGE(PG8_SB(0, 0), cB, voffB); PG8_STAGE(PG8_SA(0, 0), cA, voffA); PG8_STAGE(PG8_SB(0, 1), cB + hstep, voffB); PG8_STAGE(PG8_SA(0, 1), cA + hstep, voffA);
        if (wr == 1) PG8_BAR;
        PG8_WAIT_V(4); PG8_BAR;
        PG8_STAGE(PG8_SB(1, 0), cB + kstep, voffB); PG8_STAGE(PG8_SA(1, 0), cA + kstep, voffA); PG8_STAGE(PG8_SB(1, 1), cB + hstep + kstep, voffB);
        PG8_WAIT_V(6); PG8_BAR;
    }
    for (;;) {
        const bool has_next = S.next(ui + 1, nxt);
        const char* nA = has_next ? (const char*)g.A + (size_t)nxt.pm * tstep : cA; const char* nB = has_next ? (const char*)g.Bt + (size_t)nxt.pn * tstep : cB;
        for (int t = 0; t < nt; t += 2) {
            const bool last = (t == nt - 2);
            const char* a1 = cA + (size_t)(t + 1) * kstep;
            const char* a2 = last ? nA : cA + (size_t)(t + 2) * kstep; const char* b2 = last ? nB : cB + (size_t)(t + 2) * kstep;
            const char* a3 = a2 + kstep; const char* b3 = b2 + kstep;
            if (last && has_next) S.a_ready(nxt);
            if constexpr (SP2) {
            PG8_LDB(B0, 0, 0); PG8_LDB(B1, 0, 1); PG8_SCHED; PG8_LDA(At, 0, 0); PG8_STAGE(PG8_SA(1, 1), a1 + hstep, voffA);
            PG8_WAIT_V(8); PG8_WAIT_L(0); PG8_BAR; PG8_MMA2(0, At, 0, 0); PG8_BAR; PG8_SCHED;
            PG8_LDA(At, 0, 1); PG8_STAGE(PG8_SB(0, 0), b2, voffB); PG8_STAGE(PG8_SB(0, 1), b2 + hstep, voffB); PG8_STAGE(PG8_SA(0, 0), a2, voffA);
            PG8_WAIT_V(8); PG8_WAIT_L(0); PG8_BAR; PG8_MMA2(1, At, 0, 1); PG8_BAR; PG8_SCHED;
            PG8_LDB(B0, 1, 0); PG8_LDB(B1, 1, 1); PG8_SCHED; PG8_LDA(At, 1, 0); PG8_STAGE(PG8_SA(0, 1), a2 + hstep, voffA);
            PG8_WAIT_V(8); PG8_WAIT_L(0); PG8_BAR; PG8_MMA2(0, At, 1, 0); PG8_BAR; PG8_SCHED;
            PG8_LDA(At, 1, 1); PG8_STAGE(PG8_SB(1, 0), b3, voffB); PG8_STAGE(PG8_SB(1, 1), b3 + hstep, voffB); PG8_STAGE(PG8_SA(1, 0), a3, voffA);
            PG8_WAIT_V(8); PG8_WAIT_L(0); PG8_BAR; PG8_MMA2(1, At, 1, 1); PG8_BAR; PG8_SCHED;
            } else {
            PG8_LDB(B0, 0, 0); PG8_SCHED; PG8_LDA(At, 0, 0); PG8_STAGE(PG8_SA(1, 1), a1 + hstep, voffA);
            PG8_WAIT_L(8); PG8_BAR; PG8_WAIT_L(0); PG8_MMA(0, 0, At, B0); PG8_BAR; PG8_SCHED;
            PG8_LDB(B1, 0, 1); PG8_STAGE(PG8_SB(0, 0), b2, voffB);
            PG8_BAR; PG8_WAIT_L(0); PG8_MMA(0, 1, At, B1); PG8_BAR;
            PG8_LDA(At, 0, 1); PG8_STAGE(PG8_SA(0, 0), a2, voffA);
            PG8_BAR; PG8_WAIT_L(0); PG8_MMA(1, 0, At, B0); PG8_BAR; PG8_SCHED;
            PG8_STAGE(PG8_SB(0, 1), b2 + hstep, voffB);
            PG8_WAIT_V(6); PG8_BAR; PG8_MMA(1, 1, At, B1); PG8_BAR;
            PG8_LDB(B0, 1, 0); PG8_SCHED; PG8_LDA(At, 1, 0); PG8_STAGE(PG8_SA(0, 1), a2 + hstep, voffA);
            PG8_WAIT_L(8); PG8_BAR; PG8_WAIT_L(0); PG8_MMA(0, 0, At, B0); PG8_BAR; PG8_SCHED;
            PG8_LDB(B1, 1, 1); PG8_STAGE(PG8_SB(1, 0), b3, voffB);
            PG8_BAR; PG8_WAIT_L(0); PG8_MMA(0, 1, At, B1); PG8_BAR;
            PG8_LDA(At, 1, 1); PG8_STAGE(PG8_SA(1, 0), a3, voffA);
            PG8_BAR; PG8_WAIT_L(0); PG8_MMA(1, 0, At, B0); PG8_BAR; PG8_SCHED;
            PG8_STAGE(PG8_SB(1, 1), b3 + hstep, voffB);
            PG8_WAIT_V(6); PG8_BAR; PG8_MMA(1, 1, At, B1); PG8_BAR;
            }
        }
        if constexpr (ALIGN_EPI) { if (wr == 0) PG8_BAR; }
        if constexpr (!Epi::AFTER_DRAIN) {
            if constexpr (MODE == 2) {
                int l2; asm volatile("v_mbcnt_lo_u32_b32 %0, -1, 0\n\tv_mbcnt_hi_u32_b32 %0, -1, %0" : "=v"(l2));
                E(acc, cur, wr, wc, l2 & 15, l2 >> 4);
            } else if constexpr (Epi::PREF) E(acc, cur, wr, wc, fr, fq, pre);
            else E(acc, cur, wr, wc, fr, fq);
            S.done(cur); }
        if (!has_next) break;
#pragma unroll
        for (int a = 0; a < 2; ++a)
#pragma unroll
            for (int b = 0; b < 2; ++b)
#pragma unroll
                for (int m = 0; m < 4; ++m)
#pragma unroll
                    for (int n = 0; n < 2; ++n) acc[a][b][m][n] = (f32x4){0.f, 0.f, 0.f, 0.f};
        cur = nxt; cA = nA; cB = nB; ++ui;
        if constexpr (Epi::PREF) pre = E.prefetch(cur, wr, wc, fr, fq);
        if constexpr (ALIGN_EPI) { if (wr == 1) PG8_BAR; }
    }
    PG8_WAIT_V(0);
    if constexpr (!ALIGN_EPI) { if (wr == 0) PG8_BAR; }
    PG8_BAR;
#undef PG8_SA
#undef PG8_SB
#undef PG8_STAGE
#undef PG8_LDA
#undef PG8_LDB
#undef PG8_MMA
#undef PG8_MMA2
#undef PG8_MMAF
#undef PG8_WAIT_V
#undef PG8_WAIT_L
#undef PG8_BAR
#undef PG8_SCHED
}
}

typedef unsigned short bf16_t;
typedef short bf16x8 __attribute__((ext_vector_type(8)));
typedef float f32x4 __attribute__((ext_vector_type(4)));
typedef float f32x16 __attribute__((ext_vector_type(16)));
typedef unsigned u32x4 __attribute__((ext_vector_type(4)));
typedef unsigned u32x2 __attribute__((ext_vector_type(2)));
#define LAS __attribute__((address_space(3)))

constexpr int DM = 1024, TP = 2048, MP = 16384, TSQ = 16, MS = 128, MT = MP + MS;
constexpr int PAST = 1024, LSK = PAST + TSQ  , LSP = 1056;
constexpr int DFF = 2816, NFF2 = 5632, DIN = 2888, NZ = 3072, ZS = 2944;
constexpr int C_GB = 0, C_GC = 512, C_XV = 1024, C_Q = 1536, C_K = 2048, C_V = 2176, C_QI = 2304, C_KI = 2816;
constexpr float EPS = 1e-6f;
constexpr float QSCALE = 0.125f * 1.4426950408889634f;
constexpr float WISCALE = 0.35355339059327373f;

constexpr size_t O_Y = 0;
constexpr size_t O_KP = (size_t)MT * DM;
constexpr size_t O_VP = O_KP + (size_t)MP * 128;
constexpr size_t O_IP = O_VP + (size_t)MP * 128;
constexpr size_t O_CP = O_IP + (size_t)MP * 64;
constexpr size_t O_KS = O_CP + 8 * 2 * 512;
constexpr size_t O_VS = O_KS + (size_t)MS * 128;
constexpr size_t O_IS = O_VS + (size_t)MS * 128;
constexpr size_t O_CS = O_IS + (size_t)MS * 64;
constexpr size_t O_END = O_CS + 8 * 2 * 512;

constexpr size_t WS_CTL = 0;
constexpr size_t CTL_BYTES = 65536;
constexpr size_t WS_TAB = 65536;
constexpr size_t WS_W1Q = WS_TAB + 131072;
constexpr size_t WS_W2T = WS_W1Q + (size_t)NFF2 * DM;
constexpr size_t WS_W3T = WS_W2T + (size_t)DM * DFF * 2;
constexpr size_t WS_W4T = WS_W3T + (size_t)NZ * DM * 2;
constexpr size_t WS_W5Q = WS_W4T + (size_t)DM * DM * 2;
constexpr size_t WS_W6T = WS_W5Q + (size_t)NFF2 * DM;
constexpr size_t WS_AB = WS_W6T + (size_t)DM * DFF * 2;
constexpr size_t WS_R1 = WS_AB + (size_t)MT * DM * 2;
constexpr size_t WS_ZL = WS_R1 + (size_t)MT * ZS * 2;
constexpr size_t WS_A4 = WS_ZL + (size_t)MT * 128 * 4;
constexpr size_t WS_WIF = WS_A4 + (size_t)MT * DM * 2;
constexpr size_t WS_KP = WS_WIF + (size_t)MT * 8 * 4;
constexpr size_t WS_VTP = WS_KP + (size_t)8 * 2 * 2048 * 64 * 2;
constexpr size_t WS_KIP = WS_VTP + (size_t)8 * 2 * 2048 * 64 * 2;
constexpr size_t WS_KS = WS_KIP + (size_t)8 * 2048 * 64 * 2;
constexpr size_t WS_VTS = WS_KS + (size_t)8 * 2 * LSP * 64 * 2;
constexpr size_t WS_KIS = WS_VTS + (size_t)8 * 2 * LSP * 64 * 2;
constexpr size_t WS_PA = WS_KIS + (size_t)8 * LSP * 64 * 2;
constexpr size_t WS_PB = WS_PA + (size_t)MT * 16 * 4;
constexpr size_t WS_PC = WS_PB + (size_t)MT * 16 * 4;
constexpr size_t WS_PSB = WS_PC + (size_t)MT * 16 * 4;
constexpr size_t WS_PSC = WS_PSB + 128 * 64 * 4;
constexpr size_t WS_QIB = WS_PSC + 128 * 64 * 4;
constexpr size_t WS_XQ = WS_QIB + (size_t)MT * 512 * 2;
constexpr size_t WS_SB1 = WS_XQ + (size_t)MT * DM;
constexpr size_t WS_SB5 = WS_SB1 + (size_t)NFF2 * 4;
constexpr size_t WS_RM1 = WS_SB5 + (size_t)NFF2 * 4;
constexpr size_t WS_RM2 = WS_RM1 + (size_t)MT * 4;
constexpr size_t WS_SB6 = WS_RM2 + (size_t)MT * 4;
constexpr size_t WS_END = WS_SB6 + (size_t)DM * 4;
constexpr size_t WS_W6F = WS_W6T;
constexpr size_t WS_GB = WS_R1;
constexpr size_t WS_UB = WS_R1 + (size_t)MP * 512 * 2;
static_assert((size_t)MP * 512 * 2 * 2 <= (size_t)MP * ZS * 2, "GB/U below the sample z rows");
constexpr size_t WS_QB = WS_XQ;
static_assert((size_t)MT * 512 * 2 <= (size_t)MT * DM, "QB overlay");
static_assert(WS_END <= 268435456, "workspace map exceeds 256 MiB");
constexpr int CW_QUEUE = 64;

constexpr int LDS_BYTES = 155648;
constexpr int HIST_OFF = 141312;
constexpr int LDS_MISC = 140288;
constexpr int NWAVES = 8;

struct Args { const float* in[21]; float* out; unsigned char* ws; int ph_lo, ph_hi, coop, pad; };

__device__ __forceinline__ int lane_now() { int l; asm volatile("v_mbcnt_lo_u32_b32 %0, -1, 0\n\tv_mbcnt_hi_u32_b32 %0, -1, %0" : "=v"(l)); return l; }
__device__ __forceinline__ unsigned f2bf(float f) { unsigned u = __builtin_bit_cast(unsigned, f); return (u + 0x7fffu + ((u >> 16) & 1u)) >> 16; }
__device__ __forceinline__ unsigned pk2(float lo, float hi) { return pg8::cvt_pk_bf16(lo, hi); }
__device__ __forceinline__ float bf2f(unsigned short b) { return __builtin_bit_cast(float, (unsigned)b << 16); }
__device__ __forceinline__ float wave_sum(float v) {
#pragma unroll
    for (int o = 1; o < 64; o <<= 1) v += __shfl_xor(v, o);
    return v;
}
__device__ __forceinline__ float silu_f(float x) { return x * __builtin_amdgcn_rcpf(1.0f + __builtin_amdgcn_exp2f(-1.4426950408889634f * x)); }
__device__ __forceinline__ float rstd_from16(const float* p) {
    const f32x4 a = *(const f32x4*)p, b = *(const f32x4*)(p + 4), c = *(const f32x4*)(p + 8), d = *(const f32x4*)(p + 12);
    const float s = ((a[0] + a[1]) + (a[2] + a[3])) + ((b[0] + b[1]) + (b[2] + b[3])) + ((c[0] + c[1]) + (c[2] + c[3])) + ((d[0] + d[1]) + (d[2] + d[3]));
    return __builtin_amdgcn_rsqf(s * (1.0f / DM) + EPS);
}

struct EpiSwiGLU {
    static constexpr bool PERM = true, AFTER_DRAIN = false, PREF = false; struct Pre {};
    bf16_t* H; const float* part;
    __device__ __forceinline__ void operator()(const f32x4 (&acc)[2][2][4][2], const pg8::Unit& u, int wr, int wc, int fr, int fq) const {
        const int row0 = u.pm * 256 + wr * 64 + fr, col0 = u.pn * 128 + wc * 32 + 8 * fq;
#pragma unroll
        for (int ai = 0; ai < 2; ++ai)
#pragma unroll
            for (int m = 0; m < 4; ++m) {
                const int row = row0 + ai * 128 + m * 16;
                const float rs = rstd_from16(part + (size_t)row * 16);
                const f32x4 g0 = acc[ai][0][m][0] * rs, g1 = acc[ai][0][m][1] * rs, u0 = acc[ai][1][m][0] * rs, u1 = acc[ai][1][m][1] * rs;
                u32x4 w;
                w.x = pk2(silu_f(g0[0]) * u0[0], silu_f(g0[1]) * u0[1]); w.y = pk2(silu_f(g0[2]) * u0[2], silu_f(g0[3]) * u0[3]);
                w.z = pk2(silu_f(g1[0]) * u1[0], silu_f(g1[1]) * u1[1]); w.w = pk2(silu_f(g1[2]) * u1[2], silu_f(g1[3]) * u1[3]);
                *(u32x4*)(H + (size_t)row * DFF + col0) = w;
            }
    }
};
__device__ __forceinline__ f32x4 i2f4(const f32x4 a) { const pg8::i32x4 i = (pg8::i32x4)a; return (f32x4){(float)i[0], (float)i[1], (float)i[2], (float)i[3]}; }
__device__ __forceinline__ unsigned f8x4(float a, float b, float c, float d) { int w = 0; w = __builtin_amdgcn_cvt_pk_fp8_f32(a, b, w, false); w = __builtin_amdgcn_cvt_pk_fp8_f32(c, d, w, true); return (unsigned)w; }
template <bool F8OUT = false>
struct EpiSwiGLUQ {
    static constexpr bool PERM = true, AFTER_DRAIN = false, PREF = true;
    bf16_t* H; const float* rm; const float* cs;
    struct Pre { f32x4 cg0, cg1, cu0, cu1; float r[2][4]; };
    __device__ __forceinline__ Pre prefetch(const pg8::Unit& u, int wr, int wc, int fr, int fq) const {
        const int row0 = u.pm * 256 + wr * 64 + fr, crow = u.pn * 256 + wc * 32 + 8 * fq;
        Pre p; p.cg0 = *(const f32x4*)(cs + crow); p.cg1 = *(const f32x4*)(cs + crow + 4); p.cu0 = *(const f32x4*)(cs + crow + 128); p.cu1 = *(const f32x4*)(cs + crow + 132);
#pragma unroll
        for (int ai = 0; ai < 2; ++ai)
#pragma unroll
            for (int m = 0; m < 4; ++m) p.r[ai][m] = rm[row0 + ai * 128 + m * 16];
        return p;
    }
    __device__ __forceinline__ void operator()(const f32x4 (&acc)[2][2][4][2], const pg8::Unit& u, int wr, int wc, int fr, int fq, const Pre& pre) const {
        const int row0 = u.pm * 256 + wr * 64 + fr, col0 = u.pn * 128 + wc * 32 + 8 * fq;
        typedef float f32x2 __attribute__((ext_vector_type(2)));
        const f32x4 cl0 = pre.cg0 * -1.4426950408889634f, cl1 = pre.cg1 * -1.4426950408889634f, cp0 = pre.cg0 * pre.cu0, cp1 = pre.cg1 * pre.cu1;
#pragma unroll
        for (int ai = 0; ai < 2; ++ai)
#pragma unroll
            for (int m = 0; m < 4; ++m) {
                const int row = row0 + ai * 128 + m * 16;
                const float r = pre.r[ai][m], r2 = r * r;
                float h[8];
#pragma unroll
                for (int n = 0; n < 2; ++n) {
                    const f32x4 fg = i2f4(acc[ai][0][m][n]), fu = i2f4(acc[ai][1][m][n]);
                    const f32x4 sl = (n ? cl1 : cl0) * r, sp = (n ? cp1 : cp0) * r2;
#pragma unroll
                    for (int e2 = 0; e2 < 2; ++e2) {
                        const f32x2 g2 = (f32x2){fg[2 * e2], fg[2 * e2 + 1]}, u2 = (f32x2){fu[2 * e2], fu[2 * e2 + 1]};
                        const f32x2 t = g2 * (f32x2){sl[2 * e2], sl[2 * e2 + 1]};
                        f32x2 d = (f32x2){__builtin_amdgcn_exp2f(t.x), __builtin_amdgcn_exp2f(t.y)} + 1.0f;
                        const f32x2 rc = (f32x2){__builtin_amdgcn_rcpf(d.x), __builtin_amdgcn_rcpf(d.y)};
                        const f32x2 o = ((g2 * u2) * (f32x2){sp[2 * e2], sp[2 * e2 + 1]}) * rc;
                        h[4 * n + 2 * e2] = o.x; h[4 * n + 2 * e2 + 1] = o.y;
                    }
                }
                if constexpr (F8OUT) {
                    u32x2 w; w.x = f8x4(h[0], h[1], h[2], h[3]); w.y = f8x4(h[4], h[5], h[6], h[7]);
                    *(u32x2*)((unsigned char*)H + (size_t)row * DFF + col0) = w;
                } else {
                    u32x4 w; w.x = pk2(h[0], h[1]); w.y = pk2(h[2], h[3]); w.z = pk2(h[4], h[5]); w.w = pk2(h[6], h[7]);
                    *(u32x4*)(H + (size_t)row * DFF + col0) = w;
                }
            }
    }
};
template <int RIN, bool WOUT, bool WB, bool HALFC, bool CSC = false, bool WPART = true> struct EpiResid {
    static constexpr bool PERM = true, AFTER_DRAIN = false, PREF = false; struct Pre {};
    const float* resid; float* out; bf16_t* xb; float* part; const bf16_t* xbi;
    const float* cs;
    __device__ __forceinline__ void operator()(const f32x4 (&acc)[2][2][4][2], const pg8::Unit& u, int wr, int wc, int fr, int fq) const {
        const float coef = HALFC ? 0.5f : 1.0f;
        asm volatile("" : "+v"(fq), "+v"(fr));
        const int row0 = u.pm * 256 + wr * 64 + fr, col0 = u.pn * 256 + wc * 32 + 8 * fq;
        if constexpr (CSC) {
            f32x4 (&ma)[2][2][4][2] = const_cast<f32x4 (&)[2][2][4][2]>(acc);
#pragma unroll
            for (int bj = 0; bj < 2; ++bj) {
                const f32x4 c0 = *(const f32x4*)(cs + col0 + bj * 128), c1 = *(const f32x4*)(cs + col0 + bj * 128 + 4);
#pragma unroll
                for (int ai = 0; ai < 2; ++ai)
#pragma unroll
                    for (int m = 0; m < 4; ++m) { ma[ai][bj][m][0] = ma[ai][bj][m][0] * c0; ma[ai][bj][m][1] = ma[ai][bj][m][1] * c1; }
            }
        }
#pragma unroll
        for (int ai = 0; ai < 2; ++ai) {
            f32x4 rv[4][2][2];
#pragma unroll
            for (int m = 0; m < 4; ++m)
#pragma unroll
                for (int bj = 0; bj < 2; ++bj) {
                    const size_t off = (size_t)(row0 + ai * 128 + m * 16) * DM + col0 + bj * 128;
                    if (RIN == 0) { rv[m][bj][0] = *(const f32x4*)(resid + off); rv[m][bj][1] = *(const f32x4*)(resid + off + 4); }
                    else { const u32x4 w = *(const u32x4*)(xbi + off);
                        rv[m][bj][0] = (f32x4){__builtin_bit_cast(float, w.x << 16), __builtin_bit_cast(float, w.x & 0xffff0000u), __builtin_bit_cast(float, w.y << 16), __builtin_bit_cast(float, w.y & 0xffff0000u)};
                        rv[m][bj][1] = (f32x4){__builtin_bit_cast(float, w.z << 16), __builtin_bit_cast(float, w.z & 0xffff0000u), __builtin_bit_cast(float, w.w << 16), __builtin_bit_cast(float, w.w & 0xffff0000u)}; }
                }
#pragma unroll
            for (int m = 0; m < 4; ++m) {
                const int row = row0 + ai * 128 + m * 16; float ss = 0.f;
#pragma unroll
                for (int bj = 0; bj < 2; ++bj) {
                    const size_t off = (size_t)row * DM + col0 + bj * 128;
                    const f32x4 v0 = rv[m][bj][0] + acc[ai][bj][m][0] * coef, v1 = rv[m][bj][1] + acc[ai][bj][m][1] * coef;
                    if (WOUT) { *(f32x4*)(out + off) = v0; *(f32x4*)(out + off + 4) = v1; }
                    if (WB) {
                        u32x4 w; w.x = pk2(v0[0], v0[1]); w.y = pk2(v0[2], v0[3]); w.z = pk2(v1[0], v1[1]); w.w = pk2(v1[2], v1[3]);
                        *(u32x4*)(xb + off) = w;
                        if (WPART) ss += (v0[0] * v0[0] + v0[1] * v0[1]) + (v0[2] * v0[2] + v0[3] * v0[3]) + (v1[0] * v1[0] + v1[1] * v1[1]) + (v1[2] * v1[2] + v1[3] * v1[3]);
                    }
                }
                if (WB && WPART) { ss += __shfl_xor(ss, 16); ss += __shfl_xor(ss, 32); if (fq == 0) part[(size_t)row * 16 + u.pn * 4 + wc] = ss; }
            }
        }
    }
};
__host__ __device__ __forceinline__ int dmap_inv(int d) {
    if (d < 16) { const int r = d & 7, hi = d >> 3; return 8 * (r >> 1) + (r & 1) + 2 * hi; }
    if (d < 32) { const int dd = d - 16; return 8 * (dd >> 2) + 4 + (dd & 3); }
    const int dd = d - 32; return 128 + 8 * (dd >> 3) + 4 * ((dd >> 2) & 1) + (dd & 3);
}
__host__ __device__ __forceinline__ int dmap(int tcw) {
    const int bj = tcw >> 7, fq = (tcw >> 3) & 3, n = (tcw >> 2) & 1, e = tcw & 3;
    if (bj) return 32 + 8 * fq + 4 * n + e;
    if (n) return 16 + 4 * fq + e;
    return e < 2 ? 2 * fq + e : 2 * fq + 8 + (e - 2);
}
__host__ __device__ __forceinline__ int w3_dst(int c) {
    if (c < 512) return c;
    if (c < 1024) { const int cc = c - 512; return 256 * (2 + (cc >> 7)) + (cc & 127); }
    if (c < 1536) { const int cc = c - 1024; return 256 * (2 + (cc >> 7)) + 128 + (cc & 127); }
    if (c < 2048) { const int cc = c - 1536, h = cc >> 6; return 256 * (6 + (h >> 2)) + 32 * (h & 3) + dmap_inv(cc & 63); }
    if (c < 2176) { const int cc = c - 2048, kv = cc >> 6; return 256 * 8 + 32 * kv + dmap_inv(cc & 63); }
    if (c < 2304) { const int cc = c - 2176, kv = cc >> 6; return 256 * 8 + 32 * (2 + kv) + dmap_inv(cc & 63); }
    if (c < 2816) { const int cc = c - 2304, h = cc >> 6; return 256 * (9 + (h >> 2)) + 32 * (h & 3) + dmap_inv(cc & 63); }
    if (c < 2880) return 256 * 11 + dmap_inv(c - 2816);
    const int j = c - 2880; return 256 * 11 + 32 + 4 * (j >> 2) + (j & 3);
}
__host__ __device__ __forceinline__ int w3_src(int r) {
    const int pn = r >> 8, tc = r & 255, wc = (tc >> 5) & 3, tcw = tc & 0x9F;
    if (pn < 2) return r;
    if (pn < 6) return ((tc >> 7) ? 1024 : 512) + 128 * (pn - 2) + (tc & 127);
    if (pn < 8) return 1536 + 64 * (4 * (pn - 6) + wc) + dmap(tcw);
    if (pn == 8) return (wc < 2 ? 2048 + 64 * wc : 2176 + 64 * (wc - 2)) + dmap(tcw);
    if (pn < 11) return 2304 + 64 * (4 * (pn - 9) + wc) + dmap(tcw);
    if (wc == 0) return 2816 + dmap(tcw);
    if (wc == 1 && tcw < 8) return 2880 + tcw;
    return -1;
}
__device__ __forceinline__ size_t vt_index(int bk, int SL, int d, int s);

struct EpiZF {
    static constexpr bool PERM = true, AFTER_DRAIN = false, PREF = false; struct Pre {};
    unsigned char* ws; float* out; const float* part; const float* qn; const float* kn; const float* ikn;
    const LAS float* rsl; int pm0, pm1, pm2;
    static __device__ __forceinline__ void head_xf(f32x4& x0, f32x4& x1, f32x4& x2, f32x4& x3, bool do_norm, const float* g, bool do_rope, const float* tab, int fq) {
        if (do_norm) {
            float ss = (x0[0] * x0[0] + x0[1] * x0[1]) + (x0[2] * x0[2] + x0[3] * x0[3]) + (x1[0] * x1[0] + x1[1] * x1[1]) + (x1[2] * x1[2] + x1[3] * x1[3])
                     + (x2[0] * x2[0] + x2[1] * x2[1]) + (x2[2] * x2[2] + x2[3] * x2[3]) + (x3[0] * x3[0] + x3[1] * x3[1]) + (x3[2] * x3[2] + x3[3] * x3[3]);
            ss += __shfl_xor(ss, 16); ss += __shfl_xor(ss, 32);
            const float rn = __builtin_amdgcn_rsqf(ss * (1.0f / 64.0f) + EPS);
            const float ga0 = g[2 * fq], ga1 = g[2 * fq + 1], ga2 = g[2 * fq + 8], ga3 = g[2 * fq + 9];
            const f32x4 g1 = *(const f32x4*)(g + 16 + 4 * fq), g2 = *(const f32x4*)(g + 32 + 8 * fq), g3 = *(const f32x4*)(g + 36 + 8 * fq);
            x0 = (f32x4){x0[0] * rn * ga0, x0[1] * rn * ga1, x0[2] * rn * ga2, x0[3] * rn * ga3};
            x1 = x1 * rn * g1; x2 = x2 * rn * g2; x3 = x3 * rn * g3;
        }
        if (do_rope) {
            const float c0 = tab[2 * fq], c1 = tab[2 * fq + 1], s0 = tab[8 + 2 * fq], s1 = tab[8 + 2 * fq + 1];
            const float y0 = x0[0], y1 = x0[1], y2 = x0[2], y3 = x0[3];
            x0 = (f32x4){y0 * c0 - y2 * s0, y1 * c1 - y3 * s1, y0 * s0 + y2 * c0, y1 * s1 + y3 * c1};
        }
    }
    static __device__ __forceinline__ void st_head_bf16(bf16_t* p  , const f32x4& x0, const f32x4& x1, const f32x4& x2, const f32x4& x3, int fq) {
        *(unsigned*)(p + 2 * fq) = pk2(x0[0], x0[1]); *(unsigned*)(p + 2 * fq + 8) = pk2(x0[2], x0[3]);
        u32x2 w1; w1.x = pk2(x1[0], x1[1]); w1.y = pk2(x1[2], x1[3]); *(u32x2*)(p + 16 + 4 * fq) = w1;
        u32x4 w2; w2.x = pk2(x2[0], x2[1]); w2.y = pk2(x2[2], x2[3]); w2.z = pk2(x3[0], x3[1]); w2.w = pk2(x3[2], x3[3]); *(u32x4*)(p + 32 + 8 * fq) = w2;
    }
    static __device__ __forceinline__ void st_head_f32(float* p, const f32x4& x0, const f32x4& x1, const f32x4& x2, const f32x4& x3, int fq) {
        typedef float f32x2_ __attribute__((ext_vector_type(2)));
        *(f32x2_*)(p + 2 * fq) = (f32x2_){x0[0], x0[1]}; *(f32x2_*)(p + 2 * fq + 8) = (f32x2_){x0[2], x0[3]};
        *(f32x4*)(p + 16 + 4 * fq) = x1; *(f32x4*)(p + 32 + 8 * fq) = x2; *(f32x4*)(p + 36 + 8 * fq) = x3;
    }
    __device__ __forceinline__ void operator()(const f32x4 (&acc)[2][2][4][2], const pg8::Unit& u, int wr, int wc, int fr, int fq) const {
        asm volatile("" : "+v"(fq), "+v"(fr));
        const int row0 = u.pm * 256 + wr * 64 + fr, pn = u.pn;
        bf16_t* const GBUF = (bf16_t*)(ws + WS_GB); bf16_t* const UBUF = (bf16_t*)(ws + WS_UB); bf16_t* const QB = (bf16_t*)(ws + WS_QB); bf16_t* const QIB = (bf16_t*)(ws + WS_QIB);
        float* const WIF = (float*)(ws + WS_WIF); bf16_t* const KP = (bf16_t*)(ws + WS_KP); bf16_t* const VTP = (bf16_t*)(ws + WS_VTP); bf16_t* const KIP = (bf16_t*)(ws + WS_KIP); const float* const TAB = (const float*)(ws + WS_TAB);
#pragma unroll
        for (int ai = 0; ai < 2; ++ai)
#pragma unroll
            for (int m = 0; m < 4; ++m) {
                const int row = row0 + ai * 128 + m * 16, b = row >> 11, t = row & (TP - 1);
                const int slot = u.pm == pm0 ? 0 : (u.pm == pm1 ? 1 : (u.pm == pm2 ? 2 : -1));
                const float rs = slot >= 0 ? rsl[slot * 256 + (row & 255)] : rstd_from16(part + (size_t)row * 16);
                f32x4 x0 = acc[ai][0][m][0] * rs, x1 = acc[ai][0][m][1] * rs, x2 = acc[ai][1][m][0] * rs, x3 = acc[ai][1][m][1] * rs;
                if (pn < 2) {
                    const int c = 256 * pn + 32 * wc + 8 * fq;
                    u32x4 w; w.x = pk2(x0[0], x0[1]); w.y = pk2(x0[2], x0[3]); w.z = pk2(x1[0], x1[1]); w.w = pk2(x1[2], x1[3]); *(u32x4*)(GBUF + (size_t)row * 512 + c) = w;
                    w.x = pk2(x2[0], x2[1]); w.y = pk2(x2[2], x2[3]); w.z = pk2(x3[0], x3[1]); w.w = pk2(x3[2], x3[3]); *(u32x4*)(GBUF + (size_t)row * 512 + c + 128) = w;
                } else if (pn < 6) {
                    const int c = 128 * (pn - 2) + 32 * wc + 8 * fq;
                    const f32x4 u0 = x0 * x2, u1 = x1 * x3;
                    u32x4 w; w.x = pk2(u0[0], u0[1]); w.y = pk2(u0[2], u0[3]); w.z = pk2(u1[0], u1[1]); w.w = pk2(u1[2], u1[3]); *(u32x4*)(UBUF + (size_t)row * 512 + c) = w;
                    if (t >= TP - 2) { float* cp = out + O_CP + (size_t)(b * 2 + (t - (TP - 2))) * 512 + c; *(f32x4*)cp = u0; *(f32x4*)(cp + 4) = u1; }
                } else if (pn < 8) {
                    const int h = 4 * (pn - 6) + wc;
                    head_xf(x0, x1, x2, x3, true, qn, true, TAB + t * 16, fq);
                    x0 = x0 * QSCALE; x1 = x1 * QSCALE; x2 = x2 * QSCALE; x3 = x3 * QSCALE;
                    st_head_bf16(QB + (size_t)row * 512 + 64 * h, x0, x1, x2, x3, fq);
                } else if (pn == 8) {
                    if (wc < 2) {
                        head_xf(x0, x1, x2, x3, true, kn, true, TAB + t * 16, fq);
                        st_head_f32(out + O_KP + (size_t)row * 128 + 64 * wc, x0, x1, x2, x3, fq);
                        st_head_bf16(KP + ((size_t)(b * 2 + wc) * TP + t) * 64, x0, x1, x2, x3, fq);
                    } else {
                        const int kv = wc - 2;
                        st_head_f32(out + O_VP + (size_t)row * 128 + 64 * kv, x0, x1, x2, x3, fq);
                        bf16_t* vt = VTP + vt_index(b * 2 + kv, TP, 0, t);
                        vt[(2 * fq) * 32] = (bf16_t)f2bf(x0[0]); vt[(2 * fq + 1) * 32] = (bf16_t)f2bf(x0[1]); vt[(2 * fq + 8) * 32] = (bf16_t)f2bf(x0[2]); vt[(2 * fq + 9) * 32] = (bf16_t)f2bf(x0[3]);
#pragma unroll
                        for (int e = 0; e < 4; ++e) { vt[(16 + 4 * fq + e) * 32] = (bf16_t)f2bf(x1[e]); vt[(32 + 8 * fq + e) * 32] = (bf16_t)f2bf(x2[e]); vt[(36 + 8 * fq + e) * 32] = (bf16_t)f2bf(x3[e]); }
                    }
                } else if (pn < 11) {
                    const int h = 4 * (pn - 9) + wc;
                    head_xf(x0, x1, x2, x3, false, nullptr, true, TAB + t * 16, fq);
                    st_head_bf16(QIB + (size_t)row * 512 + 64 * h, x0, x1, x2, x3, fq);
                } else {
                    if (wc == 0) {
                        head_xf(x0, x1, x2, x3, true, ikn, true, TAB + t * 16, fq);
                        st_head_f32(out + O_IP + (size_t)row * 64, x0, x1, x2, x3, fq);
                        x0 = x0 * 0.125f; x1 = x1 * 0.125f; x2 = x2 * 0.125f; x3 = x3 * 0.125f;
                        st_head_bf16(KIP + ((size_t)b * TP + t) * 64, x0, x1, x2, x3, fq);
                    } else if (wc == 1) {
                        if (fq == 0) { float* wp = WIF + (size_t)row * 8; *(f32x4*)wp = x0 * WISCALE; *(f32x4*)(wp + 4) = x1 * WISCALE; }
                    }
                }
            }
    }
};

struct Order3 : pg8::StaticOrder {
    __device__ __forceinline__ bool next(int i, pg8::Unit& u) const { const bool ok = pg8::StaticOrder::next(i, u); u.pn = u.pn + 4 < 12 ? u.pn + 4 : u.pn - 8; return ok; }
};

template <int NB, int RB, bool I8 = false, int UNR = 2>
__device__ __forceinline__ void small_gemm_sk(const bf16_t* A  , int K, const bf16_t* B0, const bf16_t* B1, LAS unsigned char* lds, int wave, int lane, f32x4& o0, f32x4& o1) {
    const int kw = K >> 3;
    f32x4 acc[RB][NB];
#pragma unroll
    for (int rb = 0; rb < RB; ++rb)
#pragma unroll
        for (int nb = 0; nb < NB; ++nb) acc[rb][nb] = (f32x4){0.f, 0.f, 0.f, 0.f};
    const bf16_t* ap = A + (size_t)(lane & 15) * K + wave * kw + 8 * (lane >> 4);
    const bf16_t* b0 = B0 + (size_t)(lane & 15) * K + wave * kw + 8 * (lane >> 4);
    const bf16_t* b1 = B1 + (size_t)(lane & 15) * K + wave * kw + 8 * (lane >> 4);
#pragma unroll UNR
    for (int k0 = 0; k0 < kw; k0 += 32) {
        const bf16x8 x0 = *(const bf16x8*)(b0 + k0);
        bf16x8 x1 = x0;
        if (NB == 2) x1 = *(const bf16x8*)(b1 + k0);
#pragma unroll
        for (int rb = 0; rb < RB; ++rb) {
            const bf16x8 a = *(const bf16x8*)(ap + (size_t)rb * 16 * K + k0);
            acc[rb][0] = pg8::mma16<I8>(x0, a, acc[rb][0]);
            if (NB == 2) acc[rb][NB - 1] = pg8::mma16<I8>(x1, a, acc[rb][NB - 1]);
        }
    }
    LAS f32x4* P = (LAS f32x4*)lds;
    __syncthreads();
#pragma unroll
    for (int rb = 0; rb < RB; ++rb)
#pragma unroll
        for (int nb = 0; nb < NB; ++nb) P[((wave * RB + rb) * NB + nb) * 64 + lane] = acc[rb][nb];
    __syncthreads();
    f32x4 s0 = (f32x4){0.f, 0.f, 0.f, 0.f}, s1 = s0;
    if (wave < RB) {
        if constexpr (I8) {
            pg8::i32x4 t0 = (pg8::i32x4){0, 0, 0, 0}, t1 = t0;
#pragma unroll
            for (int w2 = 0; w2 < 8; ++w2) { t0 += (pg8::i32x4)P[((w2 * RB + wave) * NB + 0) * 64 + lane]; if (NB == 2) t1 += (pg8::i32x4)P[((w2 * RB + wave) * NB + (NB - 1)) * 64 + lane]; }
            s0 = (f32x4)t0; s1 = (f32x4)t1;
        } else {
#pragma unroll
            for (int w2 = 0; w2 < 8; ++w2) { s0 += P[((w2 * RB + wave) * NB + 0) * 64 + lane]; if (NB == 2) s1 += P[((w2 * RB + wave) * NB + (NB - 1)) * 64 + lane]; }
        }
    }
    o0 = s0; o1 = s1;
}
__device__ __forceinline__ float rstd_sample(const float* part, int np, int row) {
    float s = 0.f;
    for (int i = 0; i < np; i += 4) { const f32x4 a = *(const f32x4*)(part + (size_t)row * np + i); s += (a[0] + a[1]) + (a[2] + a[3]); }
    return __builtin_amdgcn_rsqf(s * (1.0f / DM) + EPS);
}
template <bool F8OUT = false>
__device__ __forceinline__ void sample_swiglu(const bf16_t* XQ, const bf16_t* WQ, bf16_t* H, const float* rm, const float* cs, int wg_lo, int nwg, int bid, LAS unsigned char* lds, int wave, int lane) {
    if (bid < wg_lo) return;
    const int tk = lane & 15, cq = lane >> 4, row = 16 * wave + tk;
    for (int it = bid - wg_lo; it < DFF / 16; it += nwg - wg_lo) {
        const int hc0 = 16 * it, grow = 256 * (hc0 >> 7) + (hc0 & 127);
        f32x4 g, u;
        small_gemm_sk<2, 8, true>(XQ + (size_t)MP * (DM / 2), DM / 2, WQ + (size_t)grow * (DM / 2), WQ + (size_t)(grow + 128) * (DM / 2), lds, wave, lane, g, u);
        const float r = rm[MP + row];
        g = i2f4(g) * (*(const f32x4*)(cs + grow + 4 * cq) * r); u = i2f4(u) * (*(const f32x4*)(cs + grow + 128 + 4 * cq) * r);
        if constexpr (F8OUT) *(unsigned*)((unsigned char*)H + (size_t)(MP + row) * DFF + hc0 + 4 * cq) = f8x4(silu_f(g[0]) * u[0], silu_f(g[1]) * u[1], silu_f(g[2]) * u[2], silu_f(g[3]) * u[3]);
        else { u32x2 w; w.x = pk2(silu_f(g[0]) * u[0], silu_f(g[1]) * u[1]); w.y = pk2(silu_f(g[2]) * u[2], silu_f(g[3]) * u[3]);
        *(u32x2*)(H + (size_t)(MP + row) * DFF + hc0 + 4 * cq) = w; }
    }
}
template <int RIN, bool WOUT, bool WB>
__device__ __forceinline__ void sample_resid(const bf16_t* A, int K, const bf16_t* W, const float* resid, float* out, float coef, bf16_t* xb, float* partS, int nwg, int bid, LAS unsigned char* lds, int wave, int lane) {
    const int tk = lane & 15, cq = lane >> 4;
    for (int it2 = bid; it2 < (DM / 16) * 4; it2 += nwg) {
        const int it = it2 >> 2, rq = it2 & 3;
        f32x4 a, dummy;
        small_gemm_sk<1, 2, false, 12>(A + (size_t)(32 * rq) * K, K, W + (size_t)(16 * it) * K, W, lds, wave, lane, a, dummy);
        if (wave < 2) {
            const int row = 32 * rq + 16 * wave + tk;
            const size_t off = (size_t)row * DM + 16 * it + 4 * cq;
            f32x4 r;
            if (RIN == 0) r = *(const f32x4*)(resid + off);
            else { const u32x2 w = *(const u32x2*)(xb + off); r = (f32x4){__builtin_bit_cast(float, w.x << 16), __builtin_bit_cast(float, w.x & 0xffff0000u), __builtin_bit_cast(float, w.y << 16), __builtin_bit_cast(float, w.y & 0xffff0000u)}; }
            const f32x4 v = r + a * coef;
            if (WOUT) *(f32x4*)(out + off) = v;
            if (WB) {
                u32x2 w; w.x = pk2(v[0], v[1]); w.y = pk2(v[2], v[3]); *(u32x2*)(xb + off) = w;
                if (partS) {
                    float ss = (v[0] * v[0] + v[1] * v[1]) + (v[2] * v[2] + v[3] * v[3]);
                    ss += __shfl_xor(ss, 16); ss += __shfl_xor(ss, 32);
                    if (cq == 0) partS[row * 64 + it] = ss;
                }
            }
        }
    }
}
__device__ __forceinline__ void sample_resid_f8(const unsigned char* A, const unsigned char* W, const float* cs, float* out, const bf16_t* xb, int nwg, int bid, LAS unsigned char* lds, int wave, int lane) {
    const int tk = lane & 15, cq = lane >> 4;
    constexpr int KB = DFF, KW = DFF / 8;
    for (int it2 = bid; it2 < (DM / 16) * 4; it2 += nwg) {
        const int it = it2 >> 2, rq = it2 & 3;
        f32x4 acc[2] = {(f32x4){0.f, 0.f, 0.f, 0.f}, (f32x4){0.f, 0.f, 0.f, 0.f}};
        const unsigned char* ap = A + (size_t)(32 * rq + tk) * KB + wave * KW + 8 * cq;
        const unsigned char* bp = W + (size_t)(16 * it + tk) * KB + wave * KW + 8 * cq;
#pragma unroll
        for (int k0 = 0; k0 < KW; k0 += 32) {
            const long x = *(const long*)(bp + k0);
#pragma unroll
            for (int rb = 0; rb < 2; ++rb) { const long a = *(const long*)(ap + (size_t)rb * 16 * KB + k0); acc[rb] = __builtin_amdgcn_mfma_f32_16x16x32_fp8_fp8(x, a, acc[rb], 0, 0, 0); }
        }
        LAS f32x4* P = (LAS f32x4*)lds;
        __syncthreads();
        P[(wave * 2 + 0) * 64 + lane] = acc[0]; P[(wave * 2 + 1) * 64 + lane] = acc[1];
        __syncthreads();
        if (wave < 2) {
            f32x4 a = (f32x4){0.f, 0.f, 0.f, 0.f};
#pragma unroll
            for (int w2 = 0; w2 < 8; ++w2) a += P[(w2 * 2 + wave) * 64 + lane];
            const int row = 32 * rq + 16 * wave + tk;
            const size_t off = (size_t)row * DM + 16 * it + 4 * cq;
            const u32x2 w = *(const u32x2*)(xb + off);
            const f32x4 r = (f32x4){__builtin_bit_cast(float, w.x << 16), __builtin_bit_cast(float, w.x & 0xffff0000u), __builtin_bit_cast(float, w.y << 16), __builtin_bit_cast(float, w.y & 0xffff0000u)};
            *(f32x4*)(out + off) = r + a * (*(const f32x4*)(cs + 16 * it + 4 * cq) * 0.5f);
        }
    }
}
__device__ __forceinline__ void sample_z(const bf16_t* AB, const bf16_t* W, bf16_t* Z, float* ZL, const float* partS, int nwg, int bid, LAS unsigned char* lds, int wave, int lane) {
    const int tk = lane & 15, cq = lane >> 4, row = 16 * wave + tk;
    for (int it = bid; it < NZ / 16; it += nwg) {
        f32x4 a, dummy;
        small_gemm_sk<1, 8>(AB + (size_t)MP * DM, DM, W + (size_t)(16 * it) * DM, W, lds, wave, lane, a, dummy);
        const float rs = rstd_sample(partS, 64, row);
        a = a * rs;
#pragma unroll
        for (int j = 0; j < 4; ++j) {
            const int c = w3_src(16 * it + 4 * cq + j);
            if (c >= 0) {
                Z[(size_t)(MP + row) * ZS + c] = (bf16_t)f2bf(a[j]);
                if (c >= C_KI) ZL[(size_t)(MP + row) * 128 + (c - C_KI)] = a[j];
            }
        }
    }
}

template <bool W3MODE = false>
__device__ __forceinline__ void p0_transpose_item(const float* W, int K, int N, const float* gain, bf16_t* WT, int drow0, int k0, int n0, LAS float* scr, int lane) {
    const int c4 = 4 * (lane & 7), n = n0 + c4;
    f32x4 v[8];
#pragma unroll
    for (int i = 0; i < 8; ++i) {
        const int kk = 8 * i + (lane >> 3);
        v[i] = (n < N) ? *(const f32x4*)(W + (size_t)(k0 + kk) * N + n) : (f32x4){0.f, 0.f, 0.f, 0.f};
    }
#pragma unroll
    for (int i = 0; i < 8; ++i) {
        const int kk = 8 * i + (lane >> 3);
        f32x4 x = v[i];
        if (gain) x = x * gain[k0 + kk];
        LAS float* d = scr + kk * 33 + c4;
        d[0] = x[0]; d[1] = x[1]; d[2] = x[2]; d[3] = x[3];
    }
    asm volatile("s_waitcnt lgkmcnt(0)" ::: "memory");
    const int c = lane & 7;
#pragma unroll
    for (int j = 0; j < 4; ++j) {
        const int nn = (lane >> 3) + 8 * j; const LAS float* sp = scr + (8 * c) * 33 + nn;
        u32x4 o; o.x = pk2(sp[0 * 33], sp[1 * 33]); o.y = pk2(sp[2 * 33], sp[3 * 33]); o.z = pk2(sp[4 * 33], sp[5 * 33]); o.w = pk2(sp[6 * 33], sp[7 * 33]);
        if (W3MODE) { if (n0 + nn < N) *(u32x4*)(WT + (size_t)w3_dst(n0 + nn) * K + k0 + 8 * c) = o; }
        else *(u32x4*)(WT + (size_t)(drow0 + nn) * K + k0 + 8 * c) = o;
    }
    asm volatile("s_waitcnt lgkmcnt(0)" ::: "memory");
}
__device__ __forceinline__ int perm16(int s) { const int i = s & 15; const int p = (i < 4 || i >= 12) ? i : (i < 8 ? i + 4 : i - 4); return (s & ~15) | p; }
__device__ __forceinline__ size_t vt_index(int bk, int SL, int d, int s) { return ((size_t)bk * SL * 64) + (size_t)(s >> 5) * 2048 + (size_t)d * 32 + (perm16(s) & 31); }

__device__ __forceinline__ unsigned q4(float a, float b, float c, float d, float inv) {
    const int i0 = (int)__builtin_rintf(a * inv), i1 = (int)__builtin_rintf(b * inv), i2 = (int)__builtin_rintf(c * inv), i3 = (int)__builtin_rintf(d * inv);
    return (unsigned)(i0 & 255) | ((unsigned)(i1 & 255) << 8) | ((unsigned)(i2 & 255) << 16) | ((unsigned)i3 << 24);
}
__device__ __forceinline__ float wave_max(float v) {
#pragma unroll
    for (int o = 1; o < 64; o <<= 1) v = fmaxf(v, __shfl_xor(v, o));
    return v;
}
__device__ __forceinline__ void quant_gu_item(const float* W, const float* gain, unsigned char* WQ, float* SB, int drow0, int n0, LAS unsigned char* lds, int tid, int lane, int wave) {
    constexpr int RSB = 1040;
    const int cq = tid & 7, kg = tid >> 3;
    f32x4 v[4][4];
#pragma unroll
    for (int i = 0; i < 4; ++i)
#pragma unroll
        for (int r = 0; r < 4; ++r) v[i][r] = *(const f32x4*)(W + (size_t)(4 * (64 * i + kg) + r) * DFF + n0 + 4 * cq);
    f32x4 mx = (f32x4){0.f, 0.f, 0.f, 0.f};
#pragma unroll
    for (int i = 0; i < 4; ++i) {
        const f32x4 gn = *(const f32x4*)(gain + 4 * (64 * i + kg));
#pragma unroll
        for (int r = 0; r < 4; ++r) { v[i][r] = v[i][r] * gn[r]; mx = __builtin_elementwise_max(mx, __builtin_elementwise_abs(v[i][r])); }
    }
#pragma unroll
    for (int e = 0; e < 4; ++e) { float t = mx[e]; t = fmaxf(t, __shfl_xor(t, 8)); t = fmaxf(t, __shfl_xor(t, 16)); t = fmaxf(t, __shfl_xor(t, 32)); mx[e] = t; }
    LAS float* red = (LAS float*)(lds + 32 * RSB);
    __syncthreads();
    if (lane < 8) *(LAS f32x4*)(red + wave * 32 + 4 * cq) = mx;
    __syncthreads();
#pragma unroll
    for (int w2 = 0; w2 < 8; ++w2) mx = __builtin_elementwise_max(mx, *(const LAS f32x4*)(red + w2 * 32 + 4 * cq));
    f32x4 inv;
#pragma unroll
    for (int e = 0; e < 4; ++e) inv[e] = mx[e] > 0.f ? 127.0f / mx[e] : 0.f;
    if (tid < 8) *(f32x4*)(SB + drow0 + 4 * cq) = mx * (1.0f / 127.0f);
#pragma unroll
    for (int i = 0; i < 4; ++i)
#pragma unroll
        for (int e = 0; e < 4; ++e)
            *(LAS unsigned*)(lds + (4 * cq + e) * RSB + 4 * (64 * i + kg)) = q4(v[i][0][e], v[i][1][e], v[i][2][e], v[i][3][e], inv[e]);
    __syncthreads();
#pragma unroll
    for (int j = 0; j < 4; ++j) {
        const int id = tid + 512 * j, row = id >> 6, c16 = id & 63;
        *(u32x4*)(WQ + (size_t)(drow0 + row) * DM + 16 * c16) = *(const LAS u32x4*)(lds + row * RSB + 16 * c16);
    }
}
__device__ __forceinline__ void quant_gu(const Args& a, int f, int it, LAS unsigned char* lds, int tid, int lane, int wave) {
    const int which = it / (DFF / 32), n0 = 32 * (it % (DFF / 32));
    quant_gu_item(a.in[f == 0 ? (which == 0 ? 7 : 8) : (which == 0 ? 18 : 19)], a.in[f == 0 ? 6 : 17], a.ws + (f == 0 ? WS_W1Q : WS_W5Q), (float*)(a.ws + (f == 0 ? WS_SB1 : WS_SB5)),
                  256 * (n0 >> 7) + (n0 & 127) + (which ? 128 : 0), n0, lds, tid, lane, wave);
}
__device__ __forceinline__ void quant_dn_item(const float* W, unsigned char* WF, float* SB, int n0, LAS unsigned char* lds, int tid, int lane, int wave) {
    constexpr int RSB = DFF + 16, NG = DFF / 4;
    const int cq = tid & 3, kg = tid >> 2;
    f32x4 v[6][4];
#pragma unroll
    for (int i = 0; i < 6; ++i)
#pragma unroll
        for (int r = 0; r < 4; ++r) { const int g = 128 * i + kg; v[i][r] = (i < 5 || g < NG) ? *(const f32x4*)(W + (size_t)(4 * g + r) * DM + n0 + 4 * cq) : (f32x4){0.f, 0.f, 0.f, 0.f}; }
    f32x4 mx = (f32x4){0.f, 0.f, 0.f, 0.f};
#pragma unroll
    for (int i = 0; i < 6; ++i)
#pragma unroll
        for (int r = 0; r < 4; ++r) mx = __builtin_elementwise_max(mx, __builtin_elementwise_abs(v[i][r]));
#pragma unroll
    for (int e = 0; e < 4; ++e) { float t = mx[e]; t = fmaxf(t, __shfl_xor(t, 4)); t = fmaxf(t, __shfl_xor(t, 8)); t = fmaxf(t, __shfl_xor(t, 16)); t = fmaxf(t, __shfl_xor(t, 32)); mx[e] = t; }
    LAS float* red = (LAS float*)(lds + 16 * RSB);
    __syncthreads();
    if (lane < 4) *(LAS f32x4*)(red + wave * 16 + 4 * cq) = mx;
    __syncthreads();
#pragma unroll
    for (int w2 = 0; w2 < 8; ++w2) mx = __builtin_elementwise_max(mx, *(const LAS f32x4*)(red + w2 * 16 + 4 * cq));
    f32x4 inv;
#pragma unroll
    for (int e = 0; e < 4; ++e) inv[e] = mx[e] > 0.f ? 256.0f / mx[e] : 0.f;
    if (tid < 4) *(f32x4*)(SB + n0 + 4 * cq) = mx * (1.0f / 256.0f);
#pragma unroll
    for (int i = 0; i < 6; ++i) {
        const int g = 128 * i + kg;
        if (i < 5 || g < NG) {
#pragma unroll
            for (int e = 0; e < 4; ++e)
                *(LAS unsigned*)(lds + (4 * cq + e) * RSB + 4 * g) = f8x4(v[i][0][e] * inv[e], v[i][1][e] * inv[e], v[i][2][e] * inv[e], v[i][3][e] * inv[e]);
        }
    }
    __syncthreads();
    for (int id = tid; id < 16 * (DFF / 16); id += 512) {
        const int row = id / (DFF / 16), c16 = id % (DFF / 16);
        *(u32x4*)(WF + (size_t)(n0 + row) * DFF + 16 * c16) = *(const LAS u32x4*)(lds + row * RSB + 16 * c16);
    }
}
constexpr int N_QDN = DM / 16;
constexpr int N_QGU = 2 * (DFF / 32);
__device__ __forceinline__ void convert_weights(const Args& a, int set, int w, int nw, LAS float* scr, int lane) {
    unsigned char* ws = a.ws;
    constexpr int I_DN = (DFF / 64) * (DM / 32), NB_IN = (DIN + 31) / 32, I_IN = (DM / 64) * NB_IN, I_OUT = (DM / 64) * (DM / 32);
    const int nitems = set == 0 ? I_DN + I_IN + I_OUT : I_DN;
    for (int it = w; it < nitems; it += nw) {
        int r = it;
        if (r < I_DN) {
            const int nblk = DM / 32, kb = r / nblk, nb = r % nblk;
            p0_transpose_item(a.in[set == 0 ? 9 : 20], DFF, DM, nullptr, (bf16_t*)(ws + (set == 0 ? WS_W2T : WS_W6T)), 32 * nb, 64 * kb, 32 * nb, scr, lane); continue; }
        r -= I_DN;
        if (r < I_IN) { const int kb = r / NB_IN, nb = r % NB_IN;
            p0_transpose_item<true>(a.in[11], DM, DIN, a.in[10], (bf16_t*)(ws + WS_W3T), 0, 64 * kb, 32 * nb, scr, lane); continue; }
        r -= I_IN;
        { const int nblk = DM / 32, kb = r / nblk, nb = r % nblk;
            p0_transpose_item(a.in[16], DM, DM, nullptr, (bf16_t*)(ws + WS_W4T), 32 * nb, 64 * kb, 32 * nb, scr, lane); }
    }
}

__device__ __forceinline__ void p0_prologue(const Args& a, LAS unsigned char* lds, int vcu, int G, int tid, int wave, int lane) {
    unsigned char* ws = a.ws;
    LAS float* scr = (LAS float*)(lds + wave * 16384);
    const int gw = vcu * NWAVES + wave, NGW = G * NWAVES;
    if (vcu < N_QGU) { quant_gu(a, 0, vcu, lds, tid, lane, wave); __syncthreads(); }
    convert_weights(a, 0, gw, NGW, scr, lane);
    for (int r = 11 * 256 + gw; r < NZ; r += NGW)
        if (w3_src(r) < 0) { u32x4* p = (u32x4*)((bf16_t*)(ws + WS_W3T) + (size_t)r * DM) + lane; p[0] = (u32x4){0u, 0u, 0u, 0u}; p[64] = (u32x4){0u, 0u, 0u, 0u}; }
    bf16_t* AB = (bf16_t*)(ws + WS_AB); float* RM = (float*)(ws + WS_RM1); unsigned* XQ = (unsigned*)(ws + WS_XQ);
    for (int m = gw; m < MT; m += NGW) {
        const float* xrow = (m < MP) ? a.in[0] + (size_t)m * DM : a.in[1] + (size_t)(m - MP) * DM;
        const f32x4* xr = (const f32x4*)xrow + lane;
        f32x4 v[4]; float s = 0.f;
#pragma unroll
        for (int j = 0; j < 4; ++j) { v[j] = xr[64 * j]; s += (v[j][0] * v[j][0] + v[j][1] * v[j][1]) + (v[j][2] * v[j][2] + v[j][3] * v[j][3]); }
        float am = 0.f;
#pragma unroll
        for (int j = 0; j < 4; ++j) am = fmaxf(fmaxf(am, fmaxf(fabsf(v[j][0]), fabsf(v[j][1]))), fmaxf(fabsf(v[j][2]), fabsf(v[j][3])));
        s = wave_sum(s); am = wave_max(am);
        const float inv = am > 0.f ? 127.0f / am : 0.f;
#pragma unroll
        for (int j = 0; j < 4; ++j) XQ[(size_t)m * (DM / 4) + 64 * j + lane] = q4(v[j][0], v[j][1], v[j][2], v[j][3], inv);
        if (lane == 0) RM[m] = __builtin_amdgcn_rsqf(s * (1.0f / DM) + EPS) * (am * (1.0f / 127.0f));
        u32x2* o8 = (u32x2*)(AB + (size_t)m * DM) + lane;
#pragma unroll
        for (int j = 0; j < 4; ++j) { u32x2 w; w.x = pk2(v[j][0], v[j][1]); w.y = pk2(v[j][2], v[j][3]); o8[64 * j] = w; }
    }
    const int gt = vcu * (NWAVES * 64) + tid, NGT = G * NWAVES * 64;
    bf16_t* KS = (bf16_t*)(ws + WS_KS); bf16_t* VTS = (bf16_t*)(ws + WS_VTS); bf16_t* KIS = (bf16_t*)(ws + WS_KIS);
    for (int e4 = gt; e4 < 8 * PAST * 128 / 4; e4 += NGT) {
        const int f = 4 * e4, d = f & 63, kv = (f >> 6) & 1, s = (f >> 7) & (PAST - 1), b = f >> 17;
        const f32x4 k = *(const f32x4*)(a.in[2] + f), v = *(const f32x4*)(a.in[3] + f);
        u32x2 w; w.x = pk2(k[0], k[1]); w.y = pk2(k[2], k[3]);
        *(u32x2*)(KS + ((size_t)(b * 2 + kv) * LSP + s) * 64 + d) = w;
        bf16_t* vt = VTS + vt_index(b * 2 + kv, LSP, d, s);
        vt[0] = (bf16_t)f2bf(v[0]); vt[32] = (bf16_t)f2bf(v[1]); vt[64] = (bf16_t)f2bf(v[2]); vt[96] = (bf16_t)f2bf(v[3]);
    }
    for (int e4 = gt; e4 < 8 * PAST * 64 / 4; e4 += NGT) {
        const int f = 4 * e4, d = f & 63, s = (f >> 6) & (PAST - 1), b = f >> 16;
        const f32x4 k = *(const f32x4*)(a.in[4] + f) * 0.125f;
        u32x2 w; w.x = pk2(k[0], k[1]); w.y = pk2(k[2], k[3]);
        *(u32x2*)(KIS + ((size_t)b * LSP + s) * 64 + d) = w;
    }
    for (int e = gt; e < 8 * 2 * 16 * 64; e += NGT) {
        const int d = e & 63, s = LSK + ((e >> 6) & 15), bk = e >> 10;
        KS[((size_t)bk * LSP + s) * 64 + d] = 0; VTS[vt_index(bk, LSP, d, s)] = 0;
    }
    for (int e = gt; e < 8 * 16 * 64; e += NGT) { const int d = e & 63, s = LSK + ((e >> 6) & 15), b = e >> 10; KIS[((size_t)b * LSP + s) * 64 + d] = 0; }
    float* TAB = (float*)(ws + WS_TAB);
    for (int e = gt; e < TP * 8; e += NGT) {
        const int pos = e >> 3, i = e & 7;
        const float invf[8] = {1.0f, 0.1939227432012558f, 0.03760603070259094f, 0.007292664609849453f, 0.0014142135623842478f, 0.00027424818836152554f, 5.318296098266728e-05f, 1.0313386155758053e-05f};
        float inv = invf[0];
#pragma unroll
        for (int j = 1; j < 8; ++j) inv = (i == j) ? invf[j] : inv;
        const float angf = (float)pos * inv;
        double x = (double)angf;
        const double TWO_PI = 6.283185307179586476925287, INV_2PI = 0.15915494309189533576888;
        double kq = __builtin_rint(x * INV_2PI); x = x - kq * TWO_PI;
        const double x2 = x * x;
        double sn = 1.0 / 51090942171709440000.0, cs = 1.0 / 2432902008176640000.0;
        const double rf[10] = {1.0 / 121645100408832000.0, 1.0 / 6402373705728000.0, 1.0 / 355687428096000.0, 1.0 / 20922789888000.0, 1.0 / 1307674368000.0, 1.0 / 87178291200.0, 1.0 / 6227020800.0, 1.0 / 479001600.0, 1.0 / 39916800.0, 1.0 / 3628800.0};
        sn = -sn * x2 + rf[0]; cs = -cs * x2 + rf[1];
        sn = -sn * x2 + rf[2]; cs = -cs * x2 + rf[3];
        sn = -sn * x2 + rf[4]; cs = -cs * x2 + rf[5];
        sn = -sn * x2 + rf[6]; cs = -cs * x2 + rf[7];
        sn = -sn * x2 + rf[8]; cs = -cs * x2 + rf[9];
        sn = -sn * x2 + 1.0 / 362880.0; cs = -cs * x2 + 1.0 / 40320.0;
        sn = -sn * x2 + 1.0 / 5040.0; cs = -cs * x2 + 1.0 / 720.0;
        sn = -sn * x2 + 1.0 / 120.0; cs = -cs * x2 + 1.0 / 24.0;
        sn = -sn * x2 + 1.0 / 6.0; cs = -cs * x2 + 0.5;
        sn = -sn * x2 + 1.0; cs = -cs * x2 + 1.0;
        sn = sn * x;
        TAB[pos * 16 + i] = (float)cs; TAB[pos * 16 + 8 + i] = (float)sn;
    }
}

template <int NR>
__device__ __forceinline__ void quant_rows(const bf16_t* X, unsigned char* XQ, float* RM, int m0, int nrows, int lane) {
    u32x4 w[NR][2];
#pragma unroll
    for (int r = 0; r < NR; ++r) { const int m = m0 + (r < nrows ? r : 0); const u32x4* xr = (const u32x4*)(X + (size_t)m * DM) + lane; w[r][0] = xr[0]; w[r][1] = xr[64]; }
#pragma unroll
    for (int r = 0; r < NR; ++r) {
        float x[16];
#pragma unroll
        for (int h = 0; h < 2; ++h)
#pragma unroll
            for (int j = 0; j < 4; ++j) { x[8 * h + 2 * j] = __builtin_bit_cast(float, w[r][h][j] << 16); x[8 * h + 2 * j + 1] = __builtin_bit_cast(float, w[r][h][j] & 0xffff0000u); }
        float s = 0.f, am = 0.f;
#pragma unroll
        for (int j = 0; j < 16; ++j) { s += x[j] * x[j]; am = fmaxf(am, fabsf(x[j])); }
        s = wave_sum(s); am = wave_max(am);
        const float inv = am > 0.f ? 127.0f / am : 0.f;
        if (r < nrows) {
            const int m = m0 + r;
#pragma unroll
            for (int h = 0; h < 2; ++h) { u32x2 o; o.x = q4(x[8 * h], x[8 * h + 1], x[8 * h + 2], x[8 * h + 3], inv); o.y = q4(x[8 * h + 4], x[8 * h + 5], x[8 * h + 6], x[8 * h + 7], inv);
                *((u32x2*)(XQ + (size_t)m * DM) + 64 * h + lane) = o; }
            if (lane == 0) RM[m] = __builtin_amdgcn_rsqf(s * (1.0f / DM) + EPS) * (am * (1.0f / 127.0f));
        }
    }
}

__device__ __forceinline__ void norm_rope8(float (&x)[8], bool do_norm, const float* gain, bool do_rope, const f32x4 (&cs)[2], const f32x4 (&sn)[2], int lane) {
    float ss = 0.f;
#pragma unroll
    for (int j = 0; j < 8; ++j) ss += x[j] * x[j];
    ss += __shfl_xor(ss, 1); ss += __shfl_xor(ss, 2); ss += __shfl_xor(ss, 4);
    const float rs = do_norm ? __builtin_amdgcn_rsqf(ss * (1.0f / 64.0f) + EPS) : 1.0f;
#pragma unroll
    for (int j = 0; j < 8; ++j) x[j] = x[j] * rs * (gain ? gain[j] : 1.0f);
    const int sub = lane & 7;
    float p[8];
#pragma unroll
    for (int j = 0; j < 8; ++j) p[j] = __shfl_xor(x[j], 1);
    if (do_rope && sub < 2) {
#pragma unroll
        for (int j = 0; j < 8; ++j) {
            const float c = cs[j >> 2][j & 3], s = sn[j >> 2][j & 3];
            x[j] = (sub == 0) ? (x[j] * c - p[j] * s) : (p[j] * s + x[j] * c);
        }
    }
}
__device__ __forceinline__ void ld8bf(const bf16_t* p, float (&x)[8]) {
    const u32x4 w = *(const u32x4*)p;
    x[0] = __builtin_bit_cast(float, w.x << 16); x[1] = __builtin_bit_cast(float, w.x & 0xffff0000u);
    x[2] = __builtin_bit_cast(float, w.y << 16); x[3] = __builtin_bit_cast(float, w.y & 0xffff0000u);
    x[4] = __builtin_bit_cast(float, w.z << 16); x[5] = __builtin_bit_cast(float, w.z & 0xffff0000u);
    x[6] = __builtin_bit_cast(float, w.w << 16); x[7] = __builtin_bit_cast(float, w.w & 0xffff0000u);
}
__device__ __forceinline__ u32x4 pk8(const float (&x)[8]) { u32x4 w; w.x = pk2(x[0], x[1]); w.y = pk2(x[2], x[3]); w.z = pk2(x[4], x[5]); w.w = pk2(x[6], x[7]); return w; }

__device__ __forceinline__ void pz_row(const Args& a, int m, int lane) {
    unsigned char* ws = a.ws;
    const bf16_t* Z = (const bf16_t*)(ws + WS_R1); const float* ZL = (const float*)(ws + WS_ZL); const float* TAB = (const float*)(ws + WS_TAB);
    bf16_t* A4 = (bf16_t*)(ws + WS_A4); bf16_t* QB = (bf16_t*)(ws + WS_QB); bf16_t* QIB = (bf16_t*)(ws + WS_QIB); float* WIF = (float*)(ws + WS_WIF);
    const float* convw = a.in[12]; const float* qn = a.in[13]; const float* kn = a.in[14]; const float* ikn = a.in[15]; const float* stc = a.in[5];
    float* out = a.out;
    {
        const bool samp = m >= MP; const int ms = m - MP;
        const int b = samp ? (ms >> 4) : (m >> 11), t = samp ? (ms & 15) : (m & 2047), pos = samp ? PAST + t : t, T = samp ? TSQ : TP;
        const bf16_t* zr = Z + (size_t)m * ZS;
        f32x4 cs[2], sn[2];
        cs[0] = *(const f32x4*)(TAB + pos * 16); cs[1] = *(const f32x4*)(TAB + pos * 16 + 4); sn[0] = *(const f32x4*)(TAB + pos * 16 + 8); sn[1] = *(const f32x4*)(TAB + pos * 16 + 12);
        {
            const int c0 = 8 * lane;
            float gb[8], gc[8], xv[8], u0[8], u1[8], u2[8];
            ld8bf(zr + C_GB + c0, gb); ld8bf(zr + C_GC + c0, gc); ld8bf(zr + C_XV + c0, xv);
#pragma unroll
            for (int j = 0; j < 8; ++j) u2[j] = gc[j] * xv[j];
            if (t >= 1) { float g1[8], x1[8]; ld8bf(zr - ZS + C_GC + c0, g1); ld8bf(zr - ZS + C_XV + c0, x1);
#pragma unroll
                for (int j = 0; j < 8; ++j) u1[j] = g1[j] * x1[j]; }
            else {
#pragma unroll
                for (int j = 0; j < 8; ++j) u1[j] = samp ? stc[(size_t)(b * 2 + 1) * 512 + c0 + j] : 0.f; }
            if (t >= 2) { float g1[8], x1[8]; ld8bf(zr - 2 * ZS + C_GC + c0, g1); ld8bf(zr - 2 * ZS + C_XV + c0, x1);
#pragma unroll
                for (int j = 0; j < 8; ++j) u0[j] = g1[j] * x1[j]; }
            else {
#pragma unroll
                for (int j = 0; j < 8; ++j) u0[j] = samp ? stc[(size_t)(b * 2 + t) * 512 + c0 + j] : 0.f; }
            float co[8];
#pragma unroll
            for (int j = 0; j < 8; ++j) co[j] = gb[j] * (u0[j] * convw[c0 + j] + u1[j] * convw[512 + c0 + j] + u2[j] * convw[1024 + c0 + j]);
            *(u32x4*)(A4 + (size_t)m * DM + c0) = pk8(co);
            if (t >= T - 2) {
                float* cp = out + (samp ? O_CS : O_CP) + (size_t)(b * 2 + (t - (T - 2))) * 512 + c0;
                *(f32x4*)cp = (f32x4){u2[0], u2[1], u2[2], u2[3]}; *(f32x4*)(cp + 4) = (f32x4){u2[4], u2[5], u2[6], u2[7]};
            }
        }
        {
            float x[8]; ld8bf(zr + C_Q + 8 * lane, x);
            float g[8];
#pragma unroll
            for (int j = 0; j < 8; ++j) g[j] = qn[8 * (lane & 7) + j];
            norm_rope8(x, true, g, true, cs, sn, lane);
#pragma unroll
            for (int j = 0; j < 8; ++j) x[j] *= QSCALE;
            *(u32x4*)(QB + (size_t)m * 512 + 8 * lane) = pk8(x);
        }
        {
            float x[8]; ld8bf(zr + C_QI + 8 * lane, x);
            norm_rope8(x, false, nullptr, true, cs, sn, lane);
            *(u32x4*)(QIB + (size_t)m * 512 + 8 * lane) = pk8(x);
        }
        {
            float x[8];
            const int role = lane >> 3;
            if (lane < 32) ld8bf(zr + C_K + 8 * lane, x);
            else if (lane < 48) { const float* zl = ZL + (size_t)m * 128 + 8 * (lane - 32); const f32x4 v0 = *(const f32x4*)zl, v1 = *(const f32x4*)(zl + 4);
                x[0] = v0[0]; x[1] = v0[1]; x[2] = v0[2]; x[3] = v0[3]; x[4] = v1[0]; x[5] = v1[1]; x[6] = v1[2]; x[7] = v1[3]; }
            else {
#pragma unroll
                for (int j = 0; j < 8; ++j) x[j] = 0.f; }
            float g[8];
#pragma unroll
            for (int j = 0; j < 8; ++j) g[j] = (role < 2) ? kn[8 * (lane & 7) + j] : (role == 4 ? ikn[8 * (lane & 7) + j] : 1.0f);
            const bool nr = (role < 2) || (role == 4);
            norm_rope8(x, nr, g, nr, cs, sn, lane);
            const int s_key = samp ? PAST + t : t;
            if (role < 2) {
                float* kp = out + (samp ? O_KS : O_KP) + ((size_t)(samp ? ms : m)) * 128 + 8 * lane;
                *(f32x4*)kp = (f32x4){x[0], x[1], x[2], x[3]}; *(f32x4*)(kp + 4) = (f32x4){x[4], x[5], x[6], x[7]};
                bf16_t* kb = samp ? (bf16_t*)(ws + WS_KS) + ((size_t)(b * 2 + role) * LSP + s_key) * 64 : (bf16_t*)(ws + WS_KP) + ((size_t)(b * 2 + role) * TP + s_key) * 64;
                *(u32x4*)(kb + 8 * (lane & 7)) = pk8(x);
            } else if (role < 4) {
                float* vp = out + (samp ? O_VS : O_VP) + ((size_t)(samp ? ms : m)) * 128 + 8 * (lane - 16);
                *(f32x4*)vp = (f32x4){x[0], x[1], x[2], x[3]}; *(f32x4*)(vp + 4) = (f32x4){x[4], x[5], x[6], x[7]};
                const int kv = role - 2, SL = samp ? LSP : TP;
                bf16_t* vt = (samp ? (bf16_t*)(ws + WS_VTS) : (bf16_t*)(ws + WS_VTP)) + vt_index(b * 2 + kv, SL, 8 * (lane & 7), s_key);
#pragma unroll
                for (int j = 0; j < 8; ++j) vt[j * 32] = (bf16_t)f2bf(x[j]);
            } else if (role == 4) {
                float* ip = out + (samp ? O_IS : O_IP) + ((size_t)(samp ? ms : m)) * 64 + 8 * (lane & 7);
                *(f32x4*)ip = (f32x4){x[0], x[1], x[2], x[3]}; *(f32x4*)(ip + 4) = (f32x4){x[4], x[5], x[6], x[7]};
#pragma unroll
                for (int j = 0; j < 8; ++j) x[j] *= 0.125f;
                bf16_t* kib = samp ? (bf16_t*)(ws + WS_KIS) + ((size_t)b * LSP + s_key) * 64 : (bf16_t*)(ws + WS_KIP) + ((size_t)b * TP + s_key) * 64;
                *(u32x4*)(kib + 8 * (lane & 7)) = pk8(x);
            } else if (lane == 40) {
                float* wp = WIF + (size_t)m * 8;
                *(f32x4*)wp = (f32x4){x[0] * WISCALE, x[1] * WISCALE, x[2] * WISCALE, x[3] * WISCALE}; *(f32x4*)(wp + 4) = (f32x4){x[4] * WISCALE, x[5] * WISCALE, x[6] * WISCALE, x[7] * WISCALE};
            }
        }
    }
}

__device__ __forceinline__ void conv_rows4(const Args& a, int mfirst, int lane) {
    unsigned char* ws = a.ws;
    const bf16_t* GBUF = (const bf16_t*)(ws + WS_GB); const bf16_t* UBUF = (const bf16_t*)(ws + WS_UB); bf16_t* A4 = (bf16_t*)(ws + WS_A4);
    const float* convw = a.in[12];
    const int c0 = 8 * lane;
    u32x4 g[4], x0[4], x1[4], x2[4];
#pragma unroll
    for (int i = 0; i < 4; ++i) {
        const int m = mfirst + 8 * i, t = m & (TP - 1);
        g[i] = *(const u32x4*)(GBUF + (size_t)m * 512 + c0); x2[i] = *(const u32x4*)(UBUF + (size_t)m * 512 + c0);
        x1[i] = (u32x4){0u, 0u, 0u, 0u}; x0[i] = (u32x4){0u, 0u, 0u, 0u};
        if (t >= 1) x1[i] = *(const u32x4*)(UBUF + (size_t)(m - 1) * 512 + c0);
        if (t >= 2) x0[i] = *(const u32x4*)(UBUF + (size_t)(m - 2) * 512 + c0);
    }
    const f32x4 wa0 = *(const f32x4*)(convw + c0), wa1 = *(const f32x4*)(convw + c0 + 4), wb0 = *(const f32x4*)(convw + 512 + c0), wb1 = *(const f32x4*)(convw + 512 + c0 + 4),
                wc0 = *(const f32x4*)(convw + 1024 + c0), wc1 = *(const f32x4*)(convw + 1024 + c0 + 4);
#pragma unroll
    for (int i = 0; i < 4; ++i) {
        const unsigned gw[4] = {g[i].x, g[i].y, g[i].z, g[i].w}, a0[4] = {x0[i].x, x0[i].y, x0[i].z, x0[i].w}, a1[4] = {x1[i].x, x1[i].y, x1[i].z, x1[i].w}, a2[4] = {x2[i].x, x2[i].y, x2[i].z, x2[i].w};
        float co[8];
#pragma unroll
        for (int j = 0; j < 8; ++j) {
            const int d = j >> 1; const bool hi = j & 1;
            const float gb = __builtin_bit_cast(float, hi ? (gw[d] & 0xffff0000u) : (gw[d] << 16));
            const float u0 = __builtin_bit_cast(float, hi ? (a0[d] & 0xffff0000u) : (a0[d] << 16));
            const float u1 = __builtin_bit_cast(float, hi ? (a1[d] & 0xffff0000u) : (a1[d] << 16));
            const float u2 = __builtin_bit_cast(float, hi ? (a2[d] & 0xffff0000u) : (a2[d] << 16));
            const float w0 = j < 4 ? wa0[j & 3] : wa1[j & 3], w1 = j < 4 ? wb0[j & 3] : wb1[j & 3], w2 = j < 4 ? wc0[j & 3] : wc1[j & 3];
            co[j] = gb * (u0 * w0 + u1 * w1 + u2 * w2);
        }
        *(u32x4*)(A4 + (size_t)(mfirst + 8 * i) * DM + c0) = pk8(co);
    }
}

#define MFMA32(a, b, c) __builtin_amdgcn_mfma_f32_32x32x16_bf16(a, b, c, 0, 0, 0)
constexpr int SC_ROW = 2056;
constexpr int BM_OFF = 32 * SC_ROW * 2, BM_ROW = 260;
constexpr int N_UNITS = 520;
#define MFMA16(a, b, c) __builtin_amdgcn_mfma_f32_16x16x32_bf16(a, b, c, 0, 0, 0)

#ifndef ATTN_REP_A
#define ATTN_REP_A 1
#endif
#ifndef ATTN_REP_SEL
#define ATTN_REP_SEL 1
#endif
#ifndef ATTN_REP_B
#define ATTN_REP_B 1
#endif
__device__ __forceinline__ int wave_incl_scan(int v) {
    v += __builtin_amdgcn_update_dpp(0, v, 0x111, 0xf, 0xf, false);
    v += __builtin_amdgcn_update_dpp(0, v, 0x112, 0xf, 0xf, false);
    v += __builtin_amdgcn_update_dpp(0, v, 0x114, 0xf, 0xf, false);
    v += __builtin_amdgcn_update_dpp(0, v, 0x118, 0xf, 0xf, false);
    v += __builtin_amdgcn_update_dpp(0, v, 0x142, 0xa, 0xf, false);
    v += __builtin_amdgcn_update_dpp(0, v, 0x143, 0xc, 0xf, false);
    return v;
}
__device__ __forceinline__ int hist_pivot(LAS unsigned* H, int target, int lane, int& above, int& here) {
    const u32x4 h4 = ((LAS u32x4*)H)[lane];
    const int s = (int)(h4.x + h4.y + h4.z + h4.w);
    const int P = wave_incl_scan(s);
    const int total = __builtin_amdgcn_readlane(P, 63);
    const int suffix = total - P + s;
    const unsigned long long m = __ballot(suffix >= target);
    const int lp = 63 - __builtin_clzll(m | 1ull);
    int ab = __builtin_amdgcn_readlane(suffix, lp) - __builtin_amdgcn_readlane(s, lp);
    const int hw = __builtin_amdgcn_readlane((int)h4.w, lp), hz = __builtin_amdgcn_readlane((int)h4.z, lp), hy = __builtin_amdgcn_readlane((int)h4.y, lp), hx = __builtin_amdgcn_readlane((int)h4.x, lp);
    int b, hr;
    if (ab + hw >= target) { b = 3; hr = hw; }
    else { ab += hw; if (ab + hz >= target) { b = 2; hr = hz; } else { ab += hz; if (ab + hy >= target) { b = 1; hr = hy; } else { ab += hy; b = 0; hr = hx; } } }
    above = ab; here = hr;
    return 4 * lp + b;
}
template <int NCH>
__device__ __forceinline__ void select_row(LAS unsigned short* SC, LAS unsigned char* BM, LAS unsigned* H, int qq, int nch, int lane) {
    unsigned key[8 * NCH];
    LAS u32x4* rowp = (LAS u32x4*)(SC + qq * SC_ROW);
    {
        u32x4 v[NCH];
#pragma unroll
        for (int i = 0; i < NCH; ++i) { v[i] = (u32x4){0u, 0u, 0u, 0u}; if (lane + 64 * i < nch) v[i] = rowp[lane + 64 * i]; }
#pragma unroll
        for (int i = 0; i < NCH; ++i) {
            const bool act = lane + 64 * i < nch;
            const unsigned w[4] = {v[i].x, v[i].y, v[i].z, v[i].w};
#pragma unroll
            for (int d = 0; d < 4; ++d) {
                const unsigned lo = w[d] & 0xffffu, hi = w[d] >> 16;
                key[8 * i + 2 * d] = act ? ((lo & 0x8000u) ? (~lo & 0xffffu) : (lo | 0x8000u)) : 0u;
                key[8 * i + 2 * d + 1] = act ? ((hi & 0x8000u) ? (~hi & 0xffffu) : (hi | 0x8000u)) : 0u;
            }
        }
    }
    unsigned T = 0u; int cgt = 0, nties = 0;
#pragma unroll 1
    for (int rep_ = 0; rep_ < ATTN_REP_SEL; ++rep_) {
        asm volatile("" : "+v"(key[0]));
        ((LAS u32x4*)H)[lane] = (u32x4){0u, 0u, 0u, 0u};
        asm volatile("" ::: "memory");
#pragma unroll
        for (int i = 0; i < NCH; ++i)
            if (lane + 64 * i < nch) {
#pragma unroll
                for (int e2 = 0; e2 < 8; ++e2) __hip_atomic_fetch_add(H + (key[8 * i + e2] >> 8), 1u, __ATOMIC_RELAXED, __HIP_MEMORY_SCOPE_WORKGROUP);
            }
        asm volatile("s_waitcnt lgkmcnt(0)" ::: "memory");
        int above1, here1;
        const unsigned p1 = (unsigned)hist_pivot(H, 256, lane, above1, here1);
        asm volatile("" ::: "memory");
        ((LAS u32x4*)H)[lane] = (u32x4){0u, 0u, 0u, 0u};
        asm volatile("" ::: "memory");
#pragma unroll
        for (int i = 0; i < NCH; ++i)
#pragma unroll
            for (int e2 = 0; e2 < 8; ++e2)
                if ((key[8 * i + e2] >> 8) == p1 && lane + 64 * i < nch) __hip_atomic_fetch_add(H + (key[8 * i + e2] & 255u), 1u, __ATOMIC_RELAXED, __HIP_MEMORY_SCOPE_WORKGROUP);
        asm volatile("s_waitcnt lgkmcnt(0)" ::: "memory");
        int above2, here2;
        const unsigned p2 = (unsigned)hist_pivot(H, 256 - above1, lane, above2, here2);
        asm volatile("" ::: "memory");
        T = (p1 << 8) | p2; cgt = above1 + above2; nties = here2;
    }
    int budget[NCH];
#pragma unroll
    for (int i = 0; i < NCH; ++i) budget[i] = 1 << 20;
    if (cgt + nties != 256) {
        int need = 256 - cgt;
#pragma unroll
        for (int i = 0; i < NCH; ++i) {
            int mine = 0;
#pragma unroll
            for (int e2 = 0; e2 < 8; ++e2) mine += (key[8 * i + e2] == T) ? 1 : 0;
            const int pre = wave_incl_scan(mine);
            budget[i] = need - (pre - mine);
            need -= __builtin_amdgcn_readlane(pre, 63);
        }
    }
#pragma unroll
    for (int i = 0; i < NCH; ++i) {
        unsigned nb = 0u; int tc = 0;
#pragma unroll
        for (int e2 = 0; e2 < 8; ++e2) {
            const bool tie = key[8 * i + e2] == T;
            const bool sel = (key[8 * i + e2] > T) || (tie && tc < budget[i]);
            tc += tie ? 1 : 0;
            nb |= sel ? 0u : (1u << e2);
        }
        if (lane + 64 * i < nch) BM[qq * BM_ROW + lane + 64 * i] = (unsigned char)nb;
    }
}

__device__ __forceinline__ void attn_unit(const Args& a, LAS unsigned char* lds, int e, int tid, int wave, int lane) {
    unsigned char* ws = a.ws;
    const int q = lane & 31, hh = lane >> 5;
    bool samp; int b, j;
    if (e < 256) { samp = false; j = 63 - (e >> 3); b = e & 7; }
    else if (e < 264) { samp = true; j = 0; b = e - 256; }
    else { samp = false; const int e2 = e - 8; j = 63 - (e2 >> 3); b = e2 & 7; }
    const int m0 = samp ? MP + 16 * b : b * TP + 32 * j;
    const int nq = samp ? 16 : 32;
    const int L = samp ? LSK : 64 * ((j >> 1) + 1);
    const int ntiles = (L + 31) >> 5;
    const int SL = samp ? LSP : TP;
    const bf16_t* Kb = samp ? (const bf16_t*)(ws + WS_KS) + (size_t)b * 2 * LSP * 64 : (const bf16_t*)(ws + WS_KP) + (size_t)b * 2 * TP * 64;
    const bf16_t* Vt = samp ? (const bf16_t*)(ws + WS_VTS) + (size_t)b * 2 * 64 * LSP : (const bf16_t*)(ws + WS_VTP) + (size_t)b * 2 * 64 * TP;
    const bf16_t* KI = samp ? (const bf16_t*)(ws + WS_KIS) + (size_t)b * LSP * 64 : (const bf16_t*)(ws + WS_KIP) + (size_t)b * TP * 64;
    LAS unsigned short* SC = (LAS unsigned short*)lds;
    LAS unsigned char* BM = lds + BM_OFF;

#if !CONV_TAIL
    if (!samp) conv_rows4(a, m0 + wave, lane);
#endif
    bf16x8 qb[2][4];
#define LOAD_QB() do { const int qrow_ = m0 + (q < nq ? q : nq - 1); const bf16_t* qp_ = (const bf16_t*)(ws + WS_QB) + (size_t)qrow_ * 512 + 128 * (wave & 3) + 8 * hh; \
        _Pragma("unroll") for (int hd = 0; hd < 2; ++hd) _Pragma("unroll") for (int ks = 0; ks < 4; ++ks) qb[hd][ks] = *(const bf16x8*)(qp_ + 64 * hd + 16 * ks); } while (0)
    if (L > 256) {
#ifndef NO_PASSA
        {
            const int q16 = lane & 15, g4 = lane >> 4, nt16 = L >> 4;
#pragma unroll 1
            for (int sw_ = 0; sw_ < ATTN_REP_A; ++sw_) {
                const int sw = wave >> 2, w4 = wave & 3; asm volatile("" ::: "memory");
                const int qi_ = 16 * sw + q16;
                bf16x8 kfa[4][2], kfb[4][2];
#define PA_LOAD(dst, base) do { _Pragma("unroll") for (int u = 0; u < 4; ++u) { int tt = (base) + 4 * u; tt = tt < nt16 ? tt : nt16 - 1; \
                        const bf16_t* kp_ = KI + (size_t)(16 * tt + q16) * 64 + 8 * g4; dst[u][0] = *(const bf16x8*)kp_; dst[u][1] = *(const bf16x8*)(kp_ + 32); } } while (0)
                PA_LOAD(kfa, w4);
                const int qrow = m0 + (qi_ < nq ? qi_ : nq - 1);
                const bf16_t* qip = (const bf16_t*)(ws + WS_QIB) + (size_t)qrow * 512 + 8 * g4;
                bf16x8 qf[8][2];
#pragma unroll
                for (int h = 0; h < 8; ++h)
#pragma unroll
                    for (int ks = 0; ks < 2; ++ks) qf[h][ks] = *(const bf16x8*)(qip + 64 * h + 32 * ks);
                const float* wip = (const float*)(ws + WS_WIF) + (size_t)qrow * 8;
                const f32x4 w0 = *(const f32x4*)wip, w1 = *(const f32x4*)(wip + 4);
                const float wi[8] = {0.5f * w0[0], 0.5f * w0[1], 0.5f * w0[2], 0.5f * w0[3], 0.5f * w1[0], 0.5f * w1[1], 0.5f * w1[2], 0.5f * w1[3]};
                bf16x8 ql[2];
#pragma unroll
                for (int ks = 0; ks < 2; ++ks) {
                    float t8[8];
#pragma unroll
                    for (int j2 = 0; j2 < 8; ++j2) t8[j2] = 0.f;
#pragma unroll
                    for (int h = 0; h < 8; ++h)
#pragma unroll
                        for (int j2 = 0; j2 < 8; ++j2) t8[j2] = __builtin_fmaf(wi[h], bf2f((unsigned short)qf[h][ks][j2]), t8[j2]);
                    u32x4 w; w.x = pk2(t8[0], t8[1]); w.y = pk2(t8[2], t8[3]); w.z = pk2(t8[4], t8[5]); w.w = pk2(t8[6], t8[7]);
                    ql[ks] = __builtin_bit_cast(bf16x8, w);
                }
#define PA_COMP(src, base) do { _Pragma("unroll") for (int u = 0; u < 4; ++u) { const int tt = (base) + 4 * u; if (tt < nt16) { \
                        f32x4 sc = (f32x4){0.f, 0.f, 0.f, 0.f}; \
                        sc = MFMA16(src[u][0], ql[0], sc); sc = MFMA16(src[u][1], ql[1], sc); \
                        _Pragma("unroll") for (int h = 0; h < 8; ++h) { f32x4 c = (f32x4){0.f, 0.f, 0.f, 0.f}; \
                            c = MFMA16(src[u][0], qf[h][0], c); c = MFMA16(src[u][1], qf[h][1], c); \
                            _Pragma("unroll") for (int r = 0; r < 4; ++r) sc[r] = __builtin_fmaf(__builtin_fabsf(c[r]), wi[h], sc[r]); } \
                        const _Float16 h0 = (_Float16)sc[0], h1 = (_Float16)sc[1], h2 = (_Float16)sc[2], h3 = (_Float16)sc[3]; \
                        u32x2 w; \
                        w.x = (unsigned)__builtin_bit_cast(unsigned short, h0) | ((unsigned)__builtin_bit_cast(unsigned short, h1) << 16); \
                        w.y = (unsigned)__builtin_bit_cast(unsigned short, h2) | ((unsigned)__builtin_bit_cast(unsigned short, h3) << 16); \
                        *(LAS u32x2*)(SC + qi_ * SC_ROW + 16 * tt + 4 * g4) = w; } } } while (0)
                for (int base = w4; base < nt16; base += 32) {
                    PA_LOAD(kfb, base + 16);
                    PA_COMP(kfa, base);
                    if (base + 16 < nt16) { PA_LOAD(kfa, base + 32); PA_COMP(kfb, base + 16); }
                }
#undef PA_LOAD
#undef PA_COMP
            }
            if (samp && tid < 32 * 8) {
                const int r = tid >> 3, d = tid & 7;
                ((LAS unsigned*)(SC + r * SC_ROW + LSK))[d] = 0xFC00FC00u;
            }
        }
#endif
        __syncthreads();
        LOAD_QB();
#ifndef NO_SEL
        {
            const int nch = ntiles * 4;
            const int ncl = (nch + 63) >> 6;
            for (int qq = wave; qq < nq; qq += 8) {
                LAS unsigned* H = (LAS unsigned*)(lds + HIST_OFF + wave * 1024);
                if (ncl == 1) select_row<1>(SC, BM, H, qq, nch, lane);
                else if (ncl == 2) select_row<2>(SC, BM, H, qq, nch, lane);
                else if (ncl == 3) select_row<3>(SC, BM, H, qq, nch, lane);
                else select_row<4>(SC, BM, H, qq, nch, lane);
            }
        }
#endif
        __syncthreads();
    } else {
        LOAD_QB();
        for (int i = tid; i < 32 * (L >> 5); i += NWAVES * 64) { const int r = i / (L >> 5), d = i % (L >> 5); ((LAS unsigned*)(BM + r * BM_ROW))[d] = 0u; }
        __syncthreads();
    }
#ifndef NO_PASSB
#pragma unroll 1
    for (int repb_ = 0; repb_ < ATTN_REP_B; ++repb_) {
        asm volatile("" ::: "memory");
        const int hp = wave & 3, par = wave >> 2, kvh = hp >> 1;
        constexpr int SLOT = 16384;
        const LAS unsigned char* ring = lds;
        const int pkv = wave >> 2, psub = wave & 3, P = psub * 64 + lane;
        const int ks_row = P >> 3, ks_c = (P & 7) ^ (ks_row & 7);
        const int vs_row = P >> 2, vs_c = (P & 3) ^ ((vs_row >> 2) & 3);
        const bf16_t* ksrc = Kb + (size_t)pkv * SL * 64 + ks_row * 64 + ks_c * 8;
        const bf16_t* vsrc = Vt + (size_t)pkv * 64 * SL + vs_row * 32 + vs_c * 8;
        const unsigned kdst = (unsigned)(pkv * 4096 + psub * 1024), vdst = (unsigned)(8192 + pkv * 4096 + psub * 1024);
#define PB_DMA(kt_) do { const int t_ = (kt_) < ntiles ? (kt_) : ntiles - 1; const int so_ = ((kt_) & 7) * SLOT; \
            __builtin_amdgcn_global_load_lds((const unsigned*)(ksrc + (size_t)t_ * 2048), (LAS unsigned*)(lds + so_ + kdst), 16, 0, 0); \
            __builtin_amdgcn_global_load_lds((const unsigned*)(vsrc + (size_t)t_ * 2048), (LAS unsigned*)(lds + so_ + vdst), 16, 0, 0); } while (0)
        const int kro = kvh * 4096 + q * 128;
        const int vro = 8192 + kvh * 4096 + q * 64;
        const LAS unsigned char* brow = BM + q * BM_ROW;
        f32x16 oa0, oa1, ob0, ob1;
#pragma unroll
        for (int r = 0; r < 16; ++r) { oa0[r] = 0.f; oa1[r] = 0.f; ob0[r] = 0.f; ob1[r] = 0.f; }
        float lsa = 0.f, lsb = 0.f;
#define PB_TILE(kt_) do { const LAS unsigned char* sb_ = ring + ((kt_) & 7) * SLOT; bf16x8 kf_[4], vf_[2][2]; \
            _Pragma("unroll") for (int ks = 0; ks < 4; ++ks) kf_[ks] = *(const LAS bf16x8*)(sb_ + kro + (((2 * ks + hh) ^ (q & 7)) << 4)); \
            _Pragma("unroll") for (int db = 0; db < 2; ++db) _Pragma("unroll") for (int s2 = 0; s2 < 2; ++s2) \
                vf_[db][s2] = *(const LAS bf16x8*)(sb_ + vro + db * 2048 + (((2 * s2 + hh) ^ ((q >> 2) & 3)) << 4)); \
            const unsigned wm_ = *(const LAS unsigned*)(brow + 4 * (kt_)) >> (4 * hh); \
            f32x16 ci_; \
            _Pragma("unroll") for (int g = 0; g < 4; ++g) _Pragma("unroll") for (int i = 0; i < 4; ++i) \
                { int t_; asm("v_bfe_i32 %0, %1, %2, 1" : "=v"(t_) : "v"(wm_), "n"(8 * g + i)); unsigned u_; asm("v_and_b32 %0, 0xff800000, %1" : "=v"(u_) : "v"(t_)); ci_[4 * g + i] = __builtin_bit_cast(float, u_); } \
            asm volatile("s_nop 1" : "+v"(ci_));        \
            f32x16 ca_ = ci_, cb_ = ci_; \
            _Pragma("unroll") for (int ks = 0; ks < 4; ++ks) ca_ = MFMA32(kf_[ks], qb[0][ks], ca_); \
            _Pragma("unroll") for (int ks = 0; ks < 4; ++ks) cb_ = MFMA32(kf_[ks], qb[1][ks], cb_); \
            { float p_[16]; _Pragma("unroll") for (int r = 0; r < 16; ++r) { p_[r] = __builtin_amdgcn_exp2f(ca_[r]); lsa += p_[r]; } \
              u32x4 pw0_, pw1_; \
              pw0_.x = pk2(p_[0], p_[1]); pw0_.y = pk2(p_[2], p_[3]); pw0_.z = pk2(p_[4], p_[5]); pw0_.w = pk2(p_[6], p_[7]); \
              pw1_.x = pk2(p_[8], p_[9]); pw1_.y = pk2(p_[10], p_[11]); pw1_.z = pk2(p_[12], p_[13]); pw1_.w = pk2(p_[14], p_[15]); \
              const bf16x8 pb0_ = __builtin_bit_cast(bf16x8, pw0_), pb1_ = __builtin_bit_cast(bf16x8, pw1_); \
              oa0 = MFMA32(vf_[0][0], pb0_, oa0); oa0 = MFMA32(vf_[0][1], pb1_, oa0); \
              oa1 = MFMA32(vf_[1][0], pb0_, oa1); oa1 = MFMA32(vf_[1][1], pb1_, oa1); } \
            { float p_[16]; _Pragma("unroll") for (int r = 0; r < 16; ++r) { p_[r] = __builtin_amdgcn_exp2f(cb_[r]); lsb += p_[r]; } \
              u32x4 pw0_, pw1_; \
              pw0_.x = pk2(p_[0], p_[1]); pw0_.y = pk2(p_[2], p_[3]); pw0_.z = pk2(p_[4], p_[5]); pw0_.w = pk2(p_[6], p_[7]); \
              pw1_.x = pk2(p_[8], p_[9]); pw1_.y = pk2(p_[10], p_[11]); pw1_.z = pk2(p_[12], p_[13]); pw1_.w = pk2(p_[14], p_[15]); \
              const bf16x8 pb0_ = __builtin_bit_cast(bf16x8, pw0_), pb1_ = __builtin_bit_cast(bf16x8, pw1_); \
              ob0 = MFMA32(vf_[0][0], pb0_, ob0); ob0 = MFMA32(vf_[0][1], pb1_, ob0); \
              ob1 = MFMA32(vf_[1][0], pb0_, ob1); ob1 = MFMA32(vf_[1][1], pb1_, ob1); } } while (0)
        asm volatile("s_waitcnt vmcnt(0) lgkmcnt(0)" ::: "memory");
        __builtin_amdgcn_s_barrier();
        PB_DMA(0); PB_DMA(1); PB_DMA(2); PB_DMA(3); PB_DMA(4);
        for (int kt = 0; kt < ntiles; kt += 2) {
            asm volatile("s_waitcnt vmcnt(6)" ::: "memory");
            __builtin_amdgcn_s_barrier(); asm volatile("" ::: "memory");
            PB_DMA(kt + 5); PB_DMA(kt + 6);
            if (kt + par < ntiles) PB_TILE(kt + par);
        }
#undef PB_TILE
        asm volatile("s_waitcnt vmcnt(0) lgkmcnt(0)" ::: "memory");
        __builtin_amdgcn_s_barrier(); asm volatile("" ::: "memory");
#undef PB_DMA
        lsa += __shfl_xor(lsa, 32); lsb += __shfl_xor(lsb, 32);
        LAS float* xch = (LAS float*)lds + (size_t)hp * (66 * 64) + lane;
        if (par == 1) {
#pragma unroll
            for (int r = 0; r < 16; ++r) { xch[(r) * 64] = oa0[r]; xch[(16 + r) * 64] = oa1[r]; xch[(32 + r) * 64] = ob0[r]; xch[(48 + r) * 64] = ob1[r]; }
            xch[64 * 64] = lsa; xch[65 * 64] = lsb;
        }
        asm volatile("s_waitcnt lgkmcnt(0)" ::: "memory");
        __builtin_amdgcn_s_barrier(); asm volatile("" ::: "memory");
        if (par == 0) {
#pragma unroll
            for (int r = 0; r < 16; ++r) { oa0[r] += xch[(r) * 64]; oa1[r] += xch[(16 + r) * 64]; ob0[r] += xch[(32 + r) * 64]; ob1[r] += xch[(48 + r) * 64]; }
            lsa += xch[64 * 64]; lsb += xch[65 * 64];
            const float inva = 1.0f / lsa, invb = 1.0f / lsb;
            if (q < nq) {
                bf16_t* op = (bf16_t*)(ws + WS_A4) + (size_t)(m0 + q) * DM + 512 + 128 * hp + 4 * hh;
#pragma unroll
                for (int g = 0; g < 4; ++g) {
                    u32x2 w0, w1;
                    w0.x = pk2(oa0[4 * g] * inva, oa0[4 * g + 1] * inva); w0.y = pk2(oa0[4 * g + 2] * inva, oa0[4 * g + 3] * inva);
                    w1.x = pk2(oa1[4 * g] * inva, oa1[4 * g + 1] * inva); w1.y = pk2(oa1[4 * g + 2] * inva, oa1[4 * g + 3] * inva);
                    *(u32x2*)(op + 8 * g) = w0; *(u32x2*)(op + 32 + 8 * g) = w1;
                    w0.x = pk2(ob0[4 * g] * invb, ob0[4 * g + 1] * invb); w0.y = pk2(ob0[4 * g + 2] * invb, ob0[4 * g + 3] * invb);
                    w1.x = pk2(ob1[4 * g] * invb, ob1[4 * g + 1] * invb); w1.y = pk2(ob1[4 * g + 2] * invb, ob1[4 * g + 3] * invb);
                    *(u32x2*)(op + 64 + 8 * g) = w0; *(u32x2*)(op + 64 + 32 + 8 * g) = w1;
                }
            }
        }
    }
#endif
    __syncthreads();
}

#define XB_TMO      128
#define XB_XCNT(j)  (256  + 64 * (j))
#define XB_XSUB(j)  (1280 + 64 * (j))
#define XB_XGEN(j)  (2304 + 64 * (j))
#define XB_TOP      3328
#define XB_TOPGEN   3392
#define XCD_BAR_WORDS 3456
#define XB_SPIN_CAP (1u << 18)
__device__ __forceinline__ unsigned xb_ld(unsigned* p)              { return __hip_atomic_load(p, __ATOMIC_RELAXED, __HIP_MEMORY_SCOPE_AGENT); }
__device__ __forceinline__ unsigned xb_add(unsigned* p, unsigned v) { return __hip_atomic_fetch_add(p, v, __ATOMIC_RELAXED, __HIP_MEMORY_SCOPE_AGENT); }
__device__ __forceinline__ unsigned xb_xcc_id() { return (unsigned)__builtin_amdgcn_s_getreg((3 << 11) | 20) & 0xFu; }
#define XB_SPIN(cond, bar) do { unsigned _sp = 0; while (cond) { __builtin_amdgcn_s_sleep(1); \
    if ((++_sp & 255u) == 0u) { if (xb_ld(&(bar)[XB_TMO])) break; if (_sp > XB_SPIN_CAP) { atomicAdd(&(bar)[XB_TMO], 1u); break; } } } } while (0)
struct XcdBarrier { unsigned* bar; unsigned x; volatile LAS unsigned* st; int wave; };
__device__ __forceinline__ XcdBarrier xcd_barrier_post(unsigned* bar, volatile LAS unsigned* st) {
    XcdBarrier b; b.bar = bar; b.x = xb_xcc_id(); b.st = st;
    if (threadIdx.x == 0) (void)xb_add(&bar[XB_XCNT(b.x)], 1u);
    return b;
}
__device__ __forceinline__ void xcd_barrier_complete(unsigned* bar, unsigned x, unsigned& nloc, unsigned& nx) {
    const unsigned G = gridDim.x * gridDim.y * gridDim.z;
    unsigned sum, cnt, mine, sp = 0u;
    for (;;) {
        sum = 0u; cnt = 0u; mine = 0u;
#pragma unroll
        for (unsigned j = 0; j < 16; ++j) { const unsigned c = xb_ld(&bar[XB_XCNT(j)]); sum += c; cnt += (c > 0u) ? 1u : 0u; mine = (j == x) ? c : mine; }
        if (sum == G) break;
        __builtin_amdgcn_s_sleep(1);
        if ((++sp & 255u) == 0u) { if (xb_ld(&bar[XB_TMO])) break; if (sp > XB_SPIN_CAP) { atomicAdd(&bar[XB_TMO], 1u); break; } }
    }
    nloc = mine > 0u ? mine : 1u; nx = cnt > 0u ? cnt : 1u;
}
__device__ __forceinline__ void xcd_barrier(const XcdBarrier& b) {
    asm volatile("s_waitcnt vmcnt(0)" ::: "memory");
    __syncthreads();
    if (b.wave == 0 && lane_now() == 0) {
        unsigned* bar = b.bar;
        __builtin_amdgcn_s_waitcnt(0);
        unsigned nloc = b.st[0], nx = b.st[1];
        if (nloc == 0u) { xcd_barrier_complete(bar, b.x, nloc, nx); b.st[0] = nloc; b.st[1] = nx; }
        const unsigned old = xb_add(&bar[XB_XSUB(b.x)], 1u);
        const unsigned gen = old / nloc;
        if (old + 1u == (gen + 1u) * nloc) {
            __builtin_amdgcn_fence(__ATOMIC_RELEASE, "agent");
            asm volatile("s_waitcnt vmcnt(0)" ::: "memory");
            const unsigned og = xb_add(&bar[XB_TOP], 1u);
            const unsigned tg = og / nx;
            if (og + 1u == (tg + 1u) * nx) xb_add(&bar[XB_TOPGEN], 1u);
            else XB_SPIN(xb_ld(&bar[XB_TOPGEN]) == tg, bar);
            __builtin_amdgcn_fence(__ATOMIC_ACQUIRE, "agent");
            xb_add(&bar[XB_XGEN(b.x)], 1u);
            asm volatile("s_waitcnt vmcnt(0)" ::: "memory");
        } else {
            XB_SPIN(xb_ld(&bar[XB_XGEN(b.x)]) == gen, bar);
            __builtin_amdgcn_fence(__ATOMIC_ACQUIRE, "agent");
            asm volatile("s_waitcnt vmcnt(0)" ::: "memory");
        }
    }
    __syncthreads();
}
constexpr int CW_BAR = 4096;

template <bool COOP>
__global__ void __launch_bounds__(NWAVES * 64, 2) fwd_kernel(Args args) {
    extern __shared__ __attribute__((aligned(16))) unsigned char lds_raw[];
    LAS unsigned char* lds = (LAS unsigned char*)lds_raw;
    const int wave = __builtin_amdgcn_readfirstlane((int)threadIdx.x >> 6);
#define lane lane_now()
#define tid (wave * 64 + lane_now())
    const int G = gridDim.x, bx = blockIdx.x;
    const int vcu = (G % 8 == 0) ? (bx % 8) * (G / 8) + bx / 8 : bx;
    unsigned char* ws = args.ws;
    float* out = args.out;
    const int lo = args.ph_lo, hi = args.ph_hi;
#ifndef PHASE_MASK
#define PHASE_MASK 0x1ff
#endif
#define IN(k) (((PHASE_MASK >> (k)) & 1) && lo <= (k) && (k) < hi)
#define SEAM(k) do { if (COOP) { if (IN(k) && IN((k) + 1)) xcd_barrier(xbar); } } while (0)
    XcdBarrier xbar; xbar.bar = (unsigned*)(ws + WS_CTL) + CW_BAR; xbar.x = 0; xbar.st = nullptr;
    if (COOP) {
        volatile LAS unsigned* st = (volatile LAS unsigned*)(lds + LDS_MISC + 16);
        if (tid < 2) st[tid] = 0u;
        __syncthreads();
        xbar = xcd_barrier_post((unsigned*)(ws + WS_CTL) + CW_BAR, st);
    }
    xbar.wave = wave;

#define AB ((bf16_t*)(ws + WS_AB))
#define R1 ((bf16_t*)(ws + WS_R1))
#define A4 ((bf16_t*)(ws + WS_A4))
#define PA ((float*)(ws + WS_PA))
#define PB ((float*)(ws + WS_PB))
#define PC ((float*)(ws + WS_PC))
#define PSB ((float*)(ws + WS_PSB))
#define PSC ((float*)(ws + WS_PSC))

    if (IN(0)) { p0_prologue(args, lds, vcu, G, tid, wave, lane); }
    SEAM(0);
    if (IN(1)) {
        pg8::Gemm g{(const bf16_t*)(ws + WS_XQ), (const bf16_t*)(ws + WS_W1Q), MP, NFF2, DM / 2}; pg8::StaticOrder S; S.init(MP, NFF2, G, bx);
        EpiSwiGLUQ<false> E{R1, (const float*)(ws + WS_RM1), (const float*)(ws + WS_SB1)};
        sample_swiglu((const bf16_t*)(ws + WS_XQ), (const bf16_t*)(ws + WS_W1Q), R1, (const float*)(ws + WS_RM1), (const float*)(ws + WS_SB1), G / 2, G, bx, lds, wave, lane);
        if (bx >= G / 2) { __syncthreads(); for (int it = bx - G / 2; it < N_QGU; it += G - G / 2) quant_gu(args, 1, it, lds, tid, lane, wave); __syncthreads(); }
        pg8::gemm_phase<EpiSwiGLUQ<false>, pg8::StaticOrder, true, true, 1>(lds, g, S, E, wave);
    }
    SEAM(1);
    if (IN(2)) {
        pg8::Gemm g{R1, (const bf16_t*)(ws + WS_W2T), MP, DM, DFF}; pg8::StaticOrder S; S.init(MP, DM, G, bx);
        EpiResid<1, false, true, true> E{nullptr, nullptr, AB, PB, AB};
        if (bx & 1) {
            sample_resid<1, false, true>(R1 + (size_t)MP * DFF, DFF, (const bf16_t*)(ws + WS_W2T), nullptr, nullptr, 0.5f, AB + (size_t)MP * DM, PSB, G, bx, lds, wave, lane);
            __syncthreads(); }
        pg8::gemm_phase<EpiResid<1, false, true, true>, pg8::StaticOrder, false, true>(lds, g, S, E, wave);
        if (!(bx & 1))
            sample_resid<1, false, true>(R1 + (size_t)MP * DFF, DFF, (const bf16_t*)(ws + WS_W2T), nullptr, nullptr, 0.5f, AB + (size_t)MP * DM, PSB, G, bx, lds, wave, lane);
    }
    SEAM(2);
    if (IN(3)) {
        pg8::Gemm g{AB, (const bf16_t*)(ws + WS_W3T), MP, NZ, DM}; Order3 S; S.init(MP, NZ, G, bx);
        EpiZF E{ws, out, PB, args.in[13], args.in[14], args.in[15], (const LAS float*)(lds + 131072), -1, -1, -1};
        {
            LAS float* rsl = (LAS float*)(lds + 131072);
            pg8::Unit uu;
            if (S.next(0, uu)) { E.pm0 = uu.pm; if (tid < 256) rsl[tid] = rstd_from16(PB + (size_t)(256 * uu.pm + tid) * 16); }
            if (S.next(1, uu)) { E.pm1 = uu.pm; if (tid >= 256) rsl[256 + (tid - 256)] = rstd_from16(PB + (size_t)(256 * uu.pm + (tid - 256)) * 16); }
            if (S.next(2, uu)) { E.pm2 = uu.pm; if (tid < 256) rsl[512 + tid] = rstd_from16(PB + (size_t)(256 * uu.pm + tid) * 16); }
            __syncthreads();
        }
        pg8::gemm_phase<EpiZF, Order3, true, true>(lds, g, S, E, wave);
        sample_z(AB, (const bf16_t*)(ws + WS_W3T), R1, (float*)(ws + WS_ZL), PSB, G, bx, lds, wave, lane);
    }
    SEAM(3);
    if (IN(4)) {
        unsigned* qhead = (unsigned*)(ws + WS_CTL) + CW_QUEUE + 64 * args.pad;
        volatile LAS int* slot = (volatile LAS int*)(lds + LDS_MISC);
        if (bx < 8) { for (int r = wave; r < TSQ; r += NWAVES) pz_row(args, MP + TSQ * bx + r, lane); __syncthreads(); }
        for (int iter = 0;; ++iter) {
            int e;
            const int nstatic = G > 8 ? (G - 8 < N_UNITS - 8 ? G - 8 : N_UNITS - 8) : 0;
            if (iter == 0 && bx < 8) e = 256 + bx;
            else {
                if (iter == 0 && bx - 8 < nstatic) e = bx - 8;
                else {
                    if (tid == 0) slot[0] = (int)atomicAdd(qhead, 1u);
                    __syncthreads();
                    e = nstatic + slot[0];
                    __syncthreads();
                }
#if CONV_TAIL
                if (e >= N_UNITS - 8) {
                    const int ci = e - (N_UNITS - 8);
                    if (ci >= MP / 32) break;
                    conv_rows4(args, 32 * ci + wave, lane);
                    continue;
                }
#else
                if (e >= N_UNITS - 8) break;
#endif
                e = e < 256 ? e : e + 8;
            }
            attn_unit(args, lds, e, tid, wave, lane);
        }
    }
    SEAM(4);
    if (IN(5)) {
        pg8::Gemm g{A4, (const bf16_t*)(ws + WS_W4T), MP, DM, DM}; pg8::StaticOrder S; S.init(MP, DM, G, bx);
        EpiResid<1, false, true, false, false, false> E{nullptr, nullptr, AB, nullptr, AB};
        if (bx & 1) {
            sample_resid<1, false, true>(A4 + (size_t)MP * DM, DM, (const bf16_t*)(ws + WS_W4T), nullptr, nullptr, 1.0f, AB + (size_t)MP * DM, nullptr, G, bx, lds, wave, lane);
            __syncthreads(); }
        pg8::gemm_phase<EpiResid<1, false, true, false, false, false>, pg8::StaticOrder, false, true>(lds, g, S, E, wave);
        if (!(bx & 1))
            sample_resid<1, false, true>(A4 + (size_t)MP * DM, DM, (const bf16_t*)(ws + WS_W4T), nullptr, nullptr, 1.0f, AB + (size_t)MP * DM, nullptr, G, bx, lds, wave, lane);
    }
    SEAM(5);
    if (IN(6)) {
        for (int g8 = vcu * NWAVES + wave; g8 < MP / 8; g8 += G * NWAVES) {
            quant_rows<4>(AB, ws + WS_XQ, (float*)(ws + WS_RM2), 8 * g8, 4, lane); quant_rows<4>(AB, ws + WS_XQ, (float*)(ws + WS_RM2), 8 * g8 + 4, 4, lane); }
        for (int g4 = vcu * NWAVES + wave; g4 < MS / 4; g4 += G * NWAVES) quant_rows<4>(AB, ws + WS_XQ, (float*)(ws + WS_RM2), MP + 4 * g4, 4, lane);
    }
    SEAM(6);
    if (IN(7)) {
        pg8::Gemm g{(const bf16_t*)(ws + WS_XQ), (const bf16_t*)(ws + WS_W5Q), MP, NFF2, DM / 2}; pg8::StaticOrder S; S.init(MP, NFF2, G, bx);
        EpiSwiGLUQ<true> E{R1, (const float*)(ws + WS_RM2), (const float*)(ws + WS_SB5)};
        sample_swiglu<true>((const bf16_t*)(ws + WS_XQ), (const bf16_t*)(ws + WS_W5Q), R1, (const float*)(ws + WS_RM2), (const float*)(ws + WS_SB5), G / 2, G, bx, lds, wave, lane);
        if (bx >= G / 2) { __syncthreads(); for (int it = bx - G / 2; it < N_QDN; it += G - G / 2) quant_dn_item(args.in[20], ws + WS_W6F, (float*)(ws + WS_SB6), 16 * it, lds, tid, lane, wave); __syncthreads(); }
        pg8::gemm_phase<EpiSwiGLUQ<true>, pg8::StaticOrder, true, true, 1>(lds, g, S, E, wave);
    }
    SEAM(7);
    if (IN(8)) {
        pg8::Gemm g{R1, (const bf16_t*)(ws + WS_W6F), MP, DM, DFF / 2}; pg8::StaticOrder S; S.init(MP, DM, G, bx);
        EpiResid<1, true, false, true, true> E{nullptr, out + O_Y, AB, nullptr, AB, (const float*)(ws + WS_SB6)};
        if (bx & 1) {
            sample_resid_f8((const unsigned char*)R1 + (size_t)MP * DFF, ws + WS_W6F, (const float*)(ws + WS_SB6), out + O_Y + (size_t)MP * DM, AB + (size_t)MP * DM, G, bx, lds, wave, lane);
            __syncthreads(); }
        pg8::gemm_phase<EpiResid<1, true, false, true, true>, pg8::StaticOrder, false, true, 2>(lds, g, S, E, wave);
        if (!(bx & 1))
            sample_resid_f8((const unsigned char*)R1 + (size_t)MP * DFF, ws + WS_W6F, (const float*)(ws + WS_SB6), out + O_Y + (size_t)MP * DM, AB + (size_t)MP * DM, G, bx, lds, wave,
                            lane_now());
    }
#undef lane
#undef tid
#undef IN
#undef SEAM
#undef AB
#undef R1
#undef A4
#undef PA
#undef PB
#undef PC
#undef PSB
#undef PSC
}

constexpr int N_PHASES = 9;
#ifndef MK_ONE_LAUNCH
#define MK_ONE_LAUNCH 1
#endif
#ifndef MK_COOP_LAUNCH
#define MK_COOP_LAUNCH 0
#endif
extern "C" void kernel_launch(void* const* d_in, const int* in_sizes, int n_in, void* d_out, int out_size, void* d_ws, size_t ws_size, hipStream_t stream) {
    static int grid = 0;
    if (grid == 0) {
        if (n_in != 21 || (size_t)out_size != O_END || ws_size < WS_END) { fprintf(stderr, "kernel_launch: unexpected sizes: n_in %d out %d ws %zu\n", n_in, out_size, ws_size); grid = -1; return; }
        int dev = 0, cus = 0;
        if (hipGetDevice(&dev) != hipSuccess || hipDeviceGetAttribute(&cus, hipDeviceAttributeMultiprocessorCount, dev) != hipSuccess) { grid = -1; return; }
        if (hipFuncSetAttribute((const void*)fwd_kernel<false>, hipFuncAttributeMaxDynamicSharedMemorySize, LDS_BYTES) != hipSuccess) { fprintf(stderr, "kernel_launch: hipFuncSetAttribute failed\n"); grid = -1; return; }
        if (hipFuncSetAttribute((const void*)fwd_kernel<true>, hipFuncAttributeMaxDynamicSharedMemorySize, LDS_BYTES) != hipSuccess) { fprintf(stderr, "kernel_launch: hipFuncSetAttribute failed\n"); grid = -1; return; }
        int per_cu = 0;
        if (hipOccupancyMaxActiveBlocksPerMultiprocessor(&per_cu, (const void*)fwd_kernel<true>, NWAVES * 64, LDS_BYTES) != hipSuccess || per_cu < 1) { fprintf(stderr, "kernel_launch: occupancy query says %d\n", per_cu); per_cu = 1; }
        (void)hipGetLastError();
        grid = cus;
    }
    if (grid < 0) return;
    (void)hipMemsetAsync((char*)d_ws + WS_CTL, 0, CTL_BYTES, stream);
    Args a{};
    for (int i = 0; i < 21; ++i) a.in[i] = (const float*)d_in[i];
    a.out = (float*)d_out; a.ws = (unsigned char*)d_ws;
#if MK_ONE_LAUNCH
    a.ph_lo = 0; a.ph_hi = N_PHASES; a.coop = 1;
#if MK_COOP_LAUNCH
    void* kargs[] = {&a};
    hipError_t e = hipLaunchCooperativeKernel((const void*)fwd_kernel<true>, dim3(grid), dim3(NWAVES * 64), kargs, LDS_BYTES, stream);
    if (e != hipSuccess) fprintf(stderr, "cooperative launch failed: %s (grid %d)\n", hipGetErrorString(e), grid);
#else
    hipLaunchKernelGGL(fwd_kernel<true>, dim3(grid), dim3(NWAVES * 64), LDS_BYTES, stream, a);
#endif
#else
    for (int p = 0; p < N_PHASES; ++p) {
        a.ph_lo = p; a.ph_hi = p + 1; a.coop = 0;
        for (int rep = 0; rep < 1 + ((REPEAT_MASK >> p) & 1); ++rep) {
            a.pad = rep;
            hipLaunchKernelGGL(fwd_kernel<false>, dim3(grid), dim3(NWAVES * 64), LDS_BYTES, stream, a);
        }
    }
#endif
}
```
